# Optimizing an MI355X kernel written in HIP

```python
import jax, jax.numpy as jnp
from jax import lax
import numpy as np

D_MODEL = 1024
BATCH = 4
SEQ = 8192
DEPTH = 2

POOL_WIDTH = D_MODEL // 2
POOL_WINDOWS = (2, 4, 8, 16)
N_POOL_GROUPS = len(POOL_WINDOWS)
POOL_GROUP = POOL_WIDTH // N_POOL_GROUPS
N_HEADS = 8
HEAD_DIM = 64
ATTN_WIDTH = N_HEADS * HEAD_DIM
Q_BLOCK = 128
IN_WIDTH = 2 * POOL_WIDTH + 4 * ATTN_WIDTH + 2 * D_MODEL
RMS_EPS = 1e-6

kernel_name = "hybrid_pool_stickbreak_gated"


def rms_norm(x, g):
    xf = x.astype(jnp.float32)
    y = xf * lax.rsqrt(jnp.mean(xf * xf, axis=-1, keepdims=True) + RMS_EPS)
    return (y * g.astype(jnp.float32)).astype(x.dtype)


def multiscale_pool(u, w_group, scale):
    B, S, _ = u.shape
    grp = u.astype(jnp.float32).reshape(B, S, N_POOL_GROUPS, POOL_GROUP)
    cs = jnp.cumsum(grp, axis=1)
    pos = jnp.arange(S)
    means = []
    for g, w in enumerate(POOL_WINDOWS):
        c = cs[:, :, g]
        prev = jnp.pad(c, ((0, 0), (w, 0), (0, 0)))[:, :S]
        cnt = jnp.minimum(pos + 1, w).astype(jnp.float32)[None, :, None]
        means.append((c - prev) / cnt)
    pooled = jnp.stack(means, axis=2) - grp
    mixed = jnp.einsum('bsgc,gcd->bsgd', pooled, w_group.astype(jnp.float32))
    return (mixed.reshape(B, S, POOL_WIDTH) * scale.astype(jnp.float32)).astype(u.dtype)


def stick_breaking_attention(q, k, v):
    B, S, H, Dh = q.shape
    n_blocks = S // Q_BLOCK
    qb = q.reshape(B, n_blocks, Q_BLOCK, H, Dh).transpose(1, 0, 2, 3, 4)
    kf = k.astype(jnp.float32)
    vf = v.astype(jnp.float32)
    key_pos = jnp.arange(S)
    inv_sqrt_d = 1.0 / float(np.sqrt(Dh))

    def one_block(args):
        q_blk, blk = args
        logits = jnp.einsum('bqhd,bkhd->bhqk', q_blk.astype(jnp.float32), kf) * inv_sqrt_d
        q_pos = blk * Q_BLOCK + jnp.arange(Q_BLOCK)
        mask = (key_pos[None, :] < q_pos[:, None])[None, None]
        log_beta = jax.nn.log_sigmoid(logits)
        log_1m_beta = jnp.where(mask, jax.nn.log_sigmoid(-logits), 0.0)
        later = lax.cumsum(log_1m_beta, axis=3, reverse=True) - log_1m_beta
        wts = jnp.where(mask, jnp.exp(log_beta + later), 0.0)
        return jnp.einsum('bhqk,bkhd->bqhd', wts, vf)

    out = lax.map(one_block, (qb, jnp.arange(n_blocks)))
    return out.transpose(1, 0, 2, 3, 4).reshape(B, S, H, Dh).astype(q.dtype)


def setup_inputs(seed: int = 0) -> dict:
    key = jax.random.key(seed)
    ks = jax.random.split(key, 11)
    f32 = jnp.float32
    x = jax.random.normal(ks[0], (BATCH, SEQ, D_MODEL), f32)
    norm_g = 1.0 + 0.05 * jax.random.normal(ks[1], (DEPTH, D_MODEL), f32)
    w_in = jax.random.normal(ks[2], (DEPTH, D_MODEL, IN_WIDTH), f32) * D_MODEL ** -0.5
    b_gate = 0.01 * jax.random.normal(ks[3], (DEPTH, 2 * D_MODEL), f32)
    pool_w = jax.random.normal(ks[4], (DEPTH, N_POOL_GROUPS, POOL_GROUP, POOL_GROUP), f32) * POOL_GROUP ** -0.5
    pool_scale = 1.0 + 0.1 * jax.random.normal(ks[5], (DEPTH, POOL_WIDTH), f32)
    w_pool_up = jax.random.normal(ks[6], (DEPTH, POOL_WIDTH, D_MODEL), f32) * POOL_WIDTH ** -0.5
    w_attn_up = jax.random.normal(ks[7], (DEPTH, ATTN_WIDTH, D_MODEL), f32) * ATTN_WIDTH ** -0.5
    w_out = jax.random.normal(ks[8], (DEPTH, D_MODEL, D_MODEL), f32) * D_MODEL ** -0.5
    final_g = 1.0 + 0.05 * jax.random.normal(ks[9], (D_MODEL,), f32)
    return {"x": x, "norm_g": norm_g, "w_in": w_in, "b_gate": b_gate, "pool_w": pool_w,
            "pool_scale": pool_scale, "w_pool_up": w_pool_up, "w_attn_up": w_attn_up,
            "w_out": w_out, "final_g": final_g}


def reference(x, norm_g, w_in, b_gate, pool_w, pool_scale, w_pool_up, w_attn_up, w_out, final_g):
    B, S, D = x.shape
    splits = np.cumsum([POOL_WIDTH, POOL_WIDTH, ATTN_WIDTH, ATTN_WIDTH, ATTN_WIDTH, ATTN_WIDTH]).tolist()
    for l in range(DEPTH):
        h = rms_norm(x, norm_g[l])
        proj = jnp.einsum('bsd,de->bse', h, w_in[l])
        u_pool, z_pool, q, k, v, z_attn, gate_logits = jnp.split(proj, splits, axis=-1)
        y_pool = multiscale_pool(u_pool, pool_w[l], pool_scale[l]) * jax.nn.silu(z_pool)
        attn = stick_breaking_attention(q.reshape(B, S, N_HEADS, HEAD_DIM),
                                        k.reshape(B, S, N_HEADS, HEAD_DIM),
                                        v.reshape(B, S, N_HEADS, HEAD_DIM))
        y_attn = attn.reshape(B, S, ATTN_WIDTH) * jax.nn.silu(z_attn)
        gates = jax.nn.sigmoid(gate_logits + b_gate[l]).reshape(B, S, 2, D)
        merged = (gates[:, :, 0] * jnp.einsum('bsp,pd->bsd', y_pool, w_pool_up[l])
                  + gates[:, :, 1] * jnp.einsum('bsa,ad->bsd', y_attn, w_attn_up[l]))
        x = x + jnp.einsum('bsd,de->bse', merged, w_out[l])
    return rms_norm(x, final_g)
```

```cpp
#include <hip/hip_runtime.h>
#include <hip/hip_cooperative_groups.h>
#include <cstdio>
#include <cstdint>
namespace cg = cooperative_groups;
namespace pg8 {
#define PG8_LAS __attribute__((address_space(3)))
typedef unsigned short bf16_t;
typedef short bf16x8 __attribute__((ext_vector_type(8)));
typedef float f32x4 __attribute__((ext_vector_type(4)));
typedef unsigned u32x4 __attribute__((ext_vector_type(4)));
constexpr int BM = 256, BK = 64, HALF = 128, HTB = HALF * BK * 2  , STAGE_BYTES = 8 * HTB, NXCD = 8, WGM = 8;

__host__ __device__ __forceinline__ int lds_byte(int r, int c) { const int st = (r >> 4) * 2 + (c >> 5), rr = r & 15, cc = c & 31, ob = rr * 64 + cc * 2; return st * 1024 + (ob ^ (((ob >> 9) & 1) << 5)); }
__host__ __device__ __forceinline__ void stage_rc(int b, int& R, int& C) { const int st = b / 1024, sb = b % 1024, swz = sb ^ (((sb >> 9) & 1) << 5); R = (st >> 1) * 16 + swz / 64; C = (st & 1) * 32 + (swz % 64) / 2; }
__host__ __device__ __forceinline__ int perm32(int rho) { const int n = rho >> 4, i = rho & 15; return 8 * (i >> 2) + 4 * n + (i & 3); }

struct Unit { int pm, pn; };
struct Gemm { const bf16_t* A; const bf16_t* Bt; int M, N, K, lda, ldb; };

struct StaticOrder {
    int nM, nN, nwg, G, c;
    __host__ __device__ void init(int M, int N, int G_, int c_) { nM = M / BM; nN = N / BM; nwg = nM * nN; G = G_; c = c_; }
    __host__ __device__ bool next(int i, Unit& u) const {
        const long L = (long)i * G + c; if (L >= nwg) return false;
        int wgid = (int)L; { const int q = nwg / NXCD, r = nwg % NXCD, xcd = wgid % NXCD, off = wgid / NXCD; wgid = (xcd < r ? xcd * (q + 1) : r * (q + 1) + (xcd - r) * q) + off; }
        const int nig = WGM * nN, gid = wgid / nig, fm = gid * WGM, gsz = (nM - fm) < WGM ? (nM - fm) : WGM;
        u.pm = fm + ((wgid % nig) % gsz); u.pn = (wgid % nig) / gsz; return true;
    }
    __device__ __forceinline__ void a_ready(const Unit&) const {}
    __device__ __forceinline__ void done(const Unit&) const {}
};

__device__ __forceinline__ unsigned cvt_pk_bf16(float lo, float hi) { unsigned r; asm volatile("v_cvt_pk_bf16_f32 %0, %1, %2" : "=v"(r) : "v"(lo), "v"(hi)); return r; }
typedef float f32x2 __attribute__((ext_vector_type(2)));
__device__ __forceinline__ float bf_lo(unsigned u) { return __uint_as_float(u << 16); }
__device__ __forceinline__ float bf_hi(unsigned u) { return __uint_as_float(u & 0xffff0000u); }
__device__ __forceinline__ float sigmoid_f(float v) { return __builtin_amdgcn_rcpf(1.0f + __builtin_amdgcn_exp2f(-1.4426950408889634f * v)); }
constexpr float RMS_EPS_F = 1e-6f;
constexpr float QSCALE = 0.125f * 1.4426950408889634f;

struct EpiProj {
    static constexpr bool PERM = true, AFTER_DRAIN = false;
    bf16_t *VP, *ZP, *Q, *K, *V, *ZA, *G; const float* ssp; const float* bgate;
    __device__ __forceinline__ void operator()(const f32x4 (&acc)[2][2][4][2], const Unit& u, int wr, int wc, int fr, int fq) const {
        const int pn = u.pn; bf16_t* base; int ld, mode, colt; float sc = 1.f;
        if (pn < 12) { const int seg = pn >> 1; colt = (pn & 1) * 256; ld = 512;
            base = seg == 0 ? VP : seg == 1 ? ZP : seg == 2 ? Q : seg == 3 ? K : seg == 4 ? V : ZA;
            mode = (seg == 1 || seg == 5) ? 1 : 0; if (seg == 2) sc = QSCALE; }
        else { base = G; colt = (pn - 12) * 256; ld = 2048; mode = 2; }
        const int row0 = u.pm * BM + wr * 64 + fr, col0 = colt + wc * 32 + 8 * fq;
        f32x4 bv[2][2];
#pragma unroll
        for (int bj = 0; bj < 2; ++bj)
#pragma unroll
            for (int n = 0; n < 2; ++n) bv[bj][n] = (mode == 2) ? *(const f32x4*)(bgate + col0 + bj * HALF + 4 * n) : (f32x4){0.f, 0.f, 0.f, 0.f};
#pragma unroll
        for (int ai = 0; ai < 2; ++ai)
#pragma unroll
            for (int m = 0; m < 4; ++m) { const int row = row0 + ai * HALF + m * 16;
                const f32x4* sp = (const f32x4*)(ssp + (size_t)row * 16); const f32x4 s0 = sp[0], s1 = sp[1], s2 = sp[2], s3 = sp[3];
                const f32x4 st = (s0 + s1) + (s2 + s3); const float ss = (st[0] + st[1]) + (st[2] + st[3]);
                const float rstd = __builtin_amdgcn_rsqf(ss * (1.0f / 1024.0f) + RMS_EPS_F) * sc;
                bf16_t* rowp = base + (size_t)row * ld + col0;
#pragma unroll
                for (int bj = 0; bj < 2; ++bj) { f32x4 v0 = acc[ai][bj][m][0] * rstd, v1 = acc[ai][bj][m][1] * rstd;
                    if (mode == 2) { v0 = v0 + bv[bj][0]; v1 = v1 + bv[bj][1];
#pragma unroll
                        for (int e = 0; e < 4; ++e) { v0[e] = sigmoid_f(v0[e]); v1[e] = sigmoid_f(v1[e]); } }
                    else if (mode == 1) {
#pragma unroll
                        for (int e = 0; e < 4; ++e) { v0[e] = v0[e] * sigmoid_f(v0[e]); v1[e] = v1[e] * sigmoid_f(v1[e]); } }
                    u32x4 w; w.x = cvt_pk_bf16(v0[0], v0[1]); w.y = cvt_pk_bf16(v0[2], v0[3]); w.z = cvt_pk_bf16(v1[0], v1[1]); w.w = cvt_pk_bf16(v1[2], v1[3]);
                    *(u32x4*)(rowp + bj * HALF) = w; } }
    }
};
template <int PASS> struct EpiMerge {
    static constexpr bool PERM = true, AFTER_DRAIN = false;
    bf16_t* MG; const bf16_t* G;
    __device__ __forceinline__ void operator()(const f32x4 (&acc)[2][2][4][2], const Unit& u, int wr, int wc, int fr, int fq) const {
        const int row0 = u.pm * BM + wr * 64 + fr, col0 = u.pn * BM + wc * 32 + 8 * fq;
#pragma unroll
        for (int ai = 0; ai < 2; ++ai)
#pragma unroll
            for (int m = 0; m < 4; ++m) { const int row = row0 + ai * HALF + m * 16;
#pragma unroll
                for (int bj = 0; bj < 2; ++bj) { const int col = col0 + bj * HALF;
                    const u32x4 gq = *(const u32x4*)(G + (size_t)row * 2048 + PASS * 1024 + col);
                    f32x4 v0 = acc[ai][bj][m][0], v1 = acc[ai][bj][m][1];
                    v0[0] *= bf_lo(gq.x); v0[1] *= bf_hi(gq.x); v0[2] *= bf_lo(gq.y); v0[3] *= bf_hi(gq.y);
                    v1[0] *= bf_lo(gq.z); v1[1] *= bf_hi(gq.z); v1[2] *= bf_lo(gq.w); v1[3] *= bf_hi(gq.w);
                    u32x4* mp = (u32x4*)(MG + (size_t)row * 1024 + col);
                    if (PASS == 1) { const u32x4 pq = *mp;
                        v0[0] += bf_lo(pq.x); v0[1] += bf_hi(pq.x); v0[2] += bf_lo(pq.y); v0[3] += bf_hi(pq.y);
                        v1[0] += bf_lo(pq.z); v1[1] += bf_hi(pq.z); v1[2] += bf_lo(pq.w); v1[3] += bf_hi(pq.w); }
                    u32x4 w; w.x = cvt_pk_bf16(v0[0], v0[1]); w.y = cvt_pk_bf16(v0[2], v0[3]); w.z = cvt_pk_bf16(v1[0], v1[1]); w.w = cvt_pk_bf16(v1[2], v1[3]);
                    *mp = w; } }
    }
};
struct EpiOut {
    static constexpr bool PERM = false, AFTER_DRAIN = false;
    const float* xin; float* xout; bf16_t* XG; const float* gnext; float* ssp; int write_xg;
    __device__ __forceinline__ void operator()(const f32x4 (&acc)[2][2][4][2], const Unit& u, int wr, int wc, int fr, int fq) const {
        typedef unsigned u32x2v __attribute__((ext_vector_type(2)));
        const int col0 = u.pn * BM + wc * 32 + 4 * fq;
#pragma unroll
        for (int ai = 0; ai < 2; ++ai)
#pragma unroll
            for (int m = 0; m < 4; ++m) { const int row = u.pm * BM + ai * HALF + wr * 64 + m * 16 + fr; const size_t off = (size_t)row * 1024 + col0; float ss = 0.f;
#pragma unroll
                for (int bj = 0; bj < 2; ++bj)
#pragma unroll
                    for (int n = 0; n < 2; ++n) { const int co = bj * HALF + n * 16;
                        const f32x4 v = *(const f32x4*)(xin + off + co) + acc[ai][bj][m][n];
                        *(f32x4*)(xout + off + co) = v; ss += (v[0] * v[0] + v[1] * v[1]) + (v[2] * v[2] + v[3] * v[3]);
                        if (write_xg) { const f32x4 gg = *(const f32x4*)(gnext + col0 + co); u32x2v w; w.x = cvt_pk_bf16(v[0] * gg[0], v[1] * gg[1]); w.y = cvt_pk_bf16(v[2] * gg[2], v[3] * gg[3]);
                            *(u32x2v*)(XG + off + co) = w; } }
                ss += __shfl_xor(ss, 16); ss += __shfl_xor(ss, 32);
                if (fq == 0) ssp[(size_t)row * 16 + u.pn * 4 + wc] = ss; }
    }
};
template <class Epi, class Sched, bool ALIGN_EPI = false, bool SP2 = false>
__device__ __forceinline__ void gemm_phase(PG8_LAS unsigned char* lds, const Gemm g_in, const Sched& S, const Epi& E) {
    Gemm g = g_in; asm volatile("" : "+s"(g.A), "+s"(g.Bt));
    int tid_ = threadIdx.x; asm volatile("" : "+v"(tid_));
    const int tid = tid_, wid = __builtin_amdgcn_readfirstlane(tid >> 6), lane = tid & 63, wr = wid >> 2, wc = wid & 3, fr = lane & 15, fq = lane >> 4;
    const int K = g.K, nt = K / BK;
    unsigned voffA[2], voffB[2];
#pragma unroll
    for (int i = 0; i < 2; ++i) { int R, C; stage_rc(tid * 16 + i * 8192, R, C); const int Rb = Epi::PERM ? ((R & ~31) + perm32(R & 31)) : R;
        voffA[i] = (unsigned)(R * g.lda + C) * 2u; voffB[i] = (unsigned)(Rb * g.ldb + C) * 2u; }
    const size_t kstep = (size_t)(BK * 2);
    const size_t hstepA = (size_t)HALF * g.lda * 2, hstepB = (size_t)HALF * g.ldb * 2;
    const size_t tstepA = 2 * hstepA, tstepB = 2 * hstepB;
    const unsigned ldsw = (unsigned)wid * 1024u;
    const int aoff = lds_byte(wr * 64 + fr, fq * 8), boff = lds_byte(wc * 32 + fr, fq * 8);
#define PG8_SA(b, h) (((b) * 2 + (h)) * HTB)
#define PG8_SB(b, h) ((4 + (b) * 2 + (h)) * HTB)
#define PG8_STAGE(bufoff, gbase, voff) do { _Pragma("unroll") for (int _i = 0; _i < 2; ++_i) \
        __builtin_amdgcn_global_load_lds((const unsigned*)((const char*)(gbase) + (voff)[_i]), (PG8_LAS unsigned*)(lds + (bufoff) + ldsw + _i * 8192), 16, 0, 0); } while (0)
#define PG8_LDA(dst, b, h) do { _Pragma("unroll") for (int m = 0; m < 4; ++m) _Pragma("unroll") for (int k = 0; k < 2; ++k) dst[m][k] = *(const PG8_LAS bf16x8*)(lds + PG8_SA(b, h) + aoff + m * 2048 + k * 1024); } while (0)
#define PG8_LDB(dst, b, h) do { _Pragma("unroll") for (int n = 0; n < 2; ++n) _Pragma("unroll") for (int k = 0; k < 2; ++k) dst[n][k] = *(const PG8_LAS bf16x8*)(lds + PG8_SB(b, h) + boff + n * 2048 + k * 1024); } while (0)
#define PG8_MMA(ai, bj, At, Bt) do { __builtin_amdgcn_s_setprio(1); _Pragma("unroll") for (int m = 0; m < 4; ++m) _Pragma("unroll") for (int n = 0; n < 2; ++n) _Pragma("unroll") for (int k = 0; k < 2; ++k) \
        acc[ai][bj][m][n] = __builtin_amdgcn_mfma_f32_16x16x32_bf16(Bt[n][k], At[m][k], acc[ai][bj][m][n], 0, 0, 0); __builtin_amdgcn_s_setprio(0); } while (0)
#define PG8_WAIT_V(n) asm volatile("s_waitcnt vmcnt(" #n ")" ::: "memory")
#define PG8_WAIT_L(n) asm volatile("s_waitcnt lgkmcnt(" #n ")" ::: "memory")
#define PG8_BAR __builtin_amdgcn_s_barrier()
#define PG8_SCHED __builtin_amdgcn_sched_barrier(0)
    Unit cur, nxt; int ui = 0;
    if (!S.next(0, cur)) return;
    f32x4 acc[2][2][4][2];
#pragma unroll
    for (int a = 0; a < 2; ++a)
#pragma unroll
        for (int b = 0; b < 2; ++b)
#pragma unroll
            for (int m = 0; m < 4; ++m)
#pragma unroll
                for (int n = 0; n < 2; ++n) acc[a][b][m][n] = (f32x4){0.f, 0.f, 0.f, 0.f};
    bf16x8 At[4][2], B0[2][2], B1[2][2];
    const char* cA = (const char*)g.A + (size_t)cur.pm * tstepA; const char* cB = (const char*)g.Bt + (size_t)cur.pn * tstepB;
    S.a_ready(cur);
    if constexpr (SP2) {
        PG8_STAGE(PG8_SB(0, 0), cB, voffB); PG8_STAGE(PG8_SB(0, 1), cB + hstepB, voffB); PG8_STAGE(PG8_SA(0, 0), cA, voffA); PG8_STAGE(PG8_SA(0, 1), cA + hstepA, voffA);
        if (wr == 1) PG8_BAR;
        PG8_WAIT_V(2); PG8_BAR;
        PG8_STAGE(PG8_SB(1, 0), cB + kstep, voffB); PG8_STAGE(PG8_SA(1, 0), cA + kstep, voffA); PG8_STAGE(PG8_SB(1, 1), cB + hstepB + kstep, voffB);
        PG8_WAIT_V(6); PG8_BAR;
    } else {
        PG8_STAGE(PG8_SB(0, 0), cB, voffB); PG8_STAGE(PG8_SA(0, 0), cA, voffA); PG8_STAGE(PG8_SB(0, 1), cB + hstepB, voffB); PG8_STAGE(PG8_SA(0, 1), cA + hstepA, voffA);
        if (wr == 1) PG8_BAR;
        PG8_WAIT_V(4); PG8_BAR;
        PG8_STAGE(PG8_SB(1, 0), cB + kstep, voffB); PG8_STAGE(PG8_SA(1, 0), cA + kstep, voffA); PG8_STAGE(PG8_SB(1, 1), cB + hstepB + kstep, voffB);
        PG8_WAIT_V(6); PG8_BAR;
    }
    for (;;) {
        const bool has_next = S.next(ui + 1, nxt);
        const char* nA = has_next ? (const char*)g.A + (size_t)nxt.pm * tstepA : cA; const char* nB = has_next ? (const char*)g.Bt + (size_t)nxt.pn * tstepB : cB;
        for (int t = 0; t < nt; t += 2) {
            const bool last = (t == nt - 2);
            const char* a1 = cA + (size_t)(t + 1) * kstep;
            const char* a2 = last ? nA : cA + (size_t)(t + 2) * kstep; const char* b2 = last ? nB : cB + (size_t)(t + 2) * kstep;
            const char* a3 = a2 + kstep; const char* b3 = b2 + kstep;
            if (last && has_next) S.a_ready(nxt);
            if constexpr (SP2) {
            PG8_LDB(B0, 0, 0); PG8_LDB(B1, 0, 1); PG8_SCHED; PG8_LDA(At, 0, 0); PG8_STAGE(PG8_SA(1, 1), a1 + hstepA, voffA);
            PG8_WAIT_V(8); PG8_WAIT_L(0); PG8_BAR; PG8_MMA(0, 0, At, B0); PG8_MMA(0, 1, At, B1); PG8_BAR; PG8_SCHED;
            PG8_LDA(At, 0, 1); PG8_STAGE(PG8_SB(0, 0), b2, voffB); PG8_STAGE(PG8_SB(0, 1), b2 + hstepB, voffB); PG8_STAGE(PG8_SA(0, 0), a2, voffA);
            PG8_WAIT_V(8); PG8_WAIT_L(0); PG8_BAR; PG8_MMA(1, 0, At, B0); PG8_MMA(1, 1, At, B1); PG8_BAR; PG8_SCHED;
            PG8_LDB(B0, 1, 0); PG8_LDB(B1, 1, 1); PG8_SCHED; PG8_LDA(At, 1, 0); PG8_STAGE(PG8_SA(0, 1), a2 + hstepA, voffA);
            PG8_WAIT_V(8); PG8_WAIT_L(0); PG8_BAR; PG8_MMA(0, 0, At, B0); PG8_MMA(0, 1, At, B1); PG8_BAR; PG8_SCHED;
            PG8_LDA(At, 1, 1); PG8_STAGE(PG8_SB(1, 0), b3, voffB); PG8_STAGE(PG8_SB(1, 1), b3 + hstepB, voffB); PG8_STAGE(PG8_SA(1, 0), a3, voffA);
            PG8_WAIT_V(8); PG8_WAIT_L(0); PG8_BAR; PG8_MMA(1, 0, At, B0); PG8_MMA(1, 1, At, B1); PG8_BAR; PG8_SCHED;
            } else {
            PG8_LDB(B0, 0, 0); PG8_SCHED; PG8_LDA(At, 0, 0); PG8_STAGE(PG8_SA(1, 1), a1 + hstepA, voffA);
            PG8_WAIT_L(8); PG8_BAR; PG8_WAIT_L(0); PG8_MMA(0, 0, At, B0); PG8_BAR; PG8_SCHED;
            PG8_LDB(B1, 0, 1); PG8_STAGE(PG8_SB(0, 0), b2, voffB);
            PG8_BAR; PG8_WAIT_L(0); PG8_MMA(0, 1, At, B1); PG8_BAR;
            PG8_LDA(At, 0, 1); PG8_STAGE(PG8_SA(0, 0), a2, voffA);
            PG8_BAR; PG8_WAIT_L(0); PG8_MMA(1, 0, At, B0); PG8_BAR; PG8_SCHED;
            PG8_STAGE(PG8_SB(0, 1), b2 + hstepB, voffB);
            PG8_WAIT_V(6); PG8_BAR; PG8_MMA(1, 1, At, B1); PG8_BAR;
            PG8_LDB(B0, 1, 0); PG8_SCHED; PG8_LDA(At, 1, 0); PG8_STAGE(PG8_SA(0, 1), a2 + hstepA, voffA);
            PG8_WAIT_L(8); PG8_BAR; PG8_WAIT_L(0); PG8_MMA(0, 0, At, B0); PG8_BAR; PG8_SCHED;
            PG8_LDB(B1, 1, 1); PG8_STAGE(PG8_SB(1, 0), b3, voffB);
            PG8_BAR; PG8_WAIT_L(0); PG8_MMA(0, 1, At, B1); PG8_BAR;
            PG8_LDA(At, 1, 1); PG8_STAGE(PG8_SA(1, 0), a3, voffA);
            PG8_BAR; PG8_WAIT_L(0); PG8_MMA(1, 0, At, B0); PG8_BAR; PG8_SCHED;
            PG8_STAGE(PG8_SB(1, 1), b3 + hstepB, voffB);
            PG8_WAIT_V(6); PG8_BAR; PG8_MMA(1, 1, At, B1); PG8_BAR;
            }
        }
        if constexpr (ALIGN_EPI) { if (wr == 0) PG8_BAR; }
        if constexpr (!Epi::AFTER_DRAIN) { int fr_ = fr, fq_ = fq; asm volatile("" : "+v"(fr_), "+v"(fq_));   E(acc, cur, wr, wc, fr_, fq_); S.done(cur); }
        if (!has_next) break;
#pragma unroll
        for (int a = 0; a < 2; ++a)
#pragma unroll
            for (int b = 0; b < 2; ++b)
#pragma unroll
                for (int m = 0; m < 4; ++m)
#pragma unroll
                    for (int n = 0; n < 2; ++n) acc[a][b][m][n] = (f32x4){0.f, 0.f, 0.f, 0.f};
        cur = nxt; cA = nA; cB = nB; ++ui;
        if constexpr (ALIGN_EPI) { if (wr == 1) PG8_BAR; }
    }
    PG8_WAIT_V(0);
    if constexpr (!ALIGN_EPI) { if (wr == 0) PG8_BAR; }
    PG8_BAR;
    if constexpr (Epi::AFTER_DRAIN) { E.fused(acc, cur, wr, wc, fr, fq, lds, wid, lane); S.done(cur); }
#undef PG8_SA
#undef PG8_SB
#undef PG8_STAGE
#undef PG8_LDA
#undef PG8_LDB
#undef PG8_MMA
#undef PG8_WAIT_V
#undef PG8_WAIT_L
#undef PG8_BAR
#undef PG8_SCHED
}
}
#define LAS __attribute__((address_space(3)))
typedef unsigned short bf16;
typedef unsigned v4u __attribute__((ext_vector_type(4)));
typedef unsigned v2u __attribute__((ext_vector_type(2)));
typedef float f32x4 __attribute__((ext_vector_type(4)));
typedef float f32x16 __attribute__((ext_vector_type(16)));
typedef short bf16x8 __attribute__((ext_vector_type(8)));
typedef short s16x4 __attribute__((ext_vector_type(4)));
constexpr int NB = 4, SEQ = 8192, DM = 1024, T = NB * SEQ, NIN = 5120, NH = 8;
constexpr size_t MiB = 1u << 20;
constexpr size_t WS_SSP = 1 * MiB;
constexpr size_t WS_W = 4 * MiB, W_LAYER = 14 * MiB;
constexpr size_t WS_XG = 32 * MiB;
constexpr size_t WS_VP = 96 * MiB, WS_ZP = 128 * MiB, WS_Q = 160 * MiB, WS_K = 192 * MiB, WS_V = 224 * MiB, WS_ZA = 256 * MiB;
constexpr size_t WS_G = 288 * MiB;
constexpr size_t WS_Y = 416 * MiB;
constexpr size_t WS_MG = WS_Q;
constexpr size_t WS_END = 480 * MiB;
constexpr int LDS_BYTES = 147456;
constexpr int NWAVES = 8, NTHREADS = 512;

__device__ __forceinline__ unsigned f2bf(float f) { unsigned u = __builtin_bit_cast(unsigned, f); return (u + 0x7fffu + ((u >> 16) & 1u)) >> 16; }
__device__ __forceinline__ unsigned pk2(float lo, float hi) { return f2bf(lo) | (f2bf(hi) << 16); }
typedef float f32x2_t __attribute__((ext_vector_type(2))); typedef __bf16 bf16x2_t __attribute__((ext_vector_type(2)));
__device__ __forceinline__ unsigned cvtpk(float lo, float hi) { f32x2_t v = {lo, hi}; bf16x2_t b = __builtin_convertvector(v, bf16x2_t); return __builtin_bit_cast(unsigned, b); }
__device__ __forceinline__ float bflo(unsigned u) { return __uint_as_float(u << 16); }
__device__ __forceinline__ float bfhi(unsigned u) { return __uint_as_float(u & 0xffff0000u); }
__device__ __forceinline__ float wave_sum(float v) {
#pragma unroll
    for (int o = 1; o < 64; o <<= 1) v += __shfl_xor(v, o);
    return v;
}
#define LDS_WAIT() asm volatile("s_waitcnt lgkmcnt(0)" ::: "memory")

__device__ __forceinline__ void tr_item(const float* W, int ldw, bf16* WT, int ldt, int k0, int n0, int trow0, int tcol0, LAS float* scr, int lane) {
#pragma unroll 8
    for (int i = 0; i < 32; ++i) { const int kk = 2 * i + (lane >> 5); scr[kk * 33 + (lane & 31)] = W[(size_t)(k0 + kk) * ldw + n0 + (lane & 31)]; }
    LDS_WAIT();
    const int c = lane & 7;
#pragma unroll
    for (int j = 0; j < 4; ++j) { const int n = (lane >> 3) + 8 * j; const LAS float* s = scr + (8 * c) * 33 + n;
        v4u o; o.x = pk2(s[0 * 33], s[1 * 33]); o.y = pk2(s[2 * 33], s[3 * 33]); o.z = pk2(s[4 * 33], s[5 * 33]); o.w = pk2(s[6 * 33], s[7 * 33]);
        *(v4u*)(WT + (size_t)(trow0 + n) * ldt + tcol0 + 8 * c) = o; }
    LDS_WAIT();
}

constexpr int VPITCH = 144;
constexpr float SB_EXIT = 160.0f;
__device__ __forceinline__ int crow(int r, int hi) { return (r & 3) + 8 * (r >> 2) + 4 * hi; }
__device__ __forceinline__ s16x4 vtr(const LAS unsigned char* p) { typedef short v4i16_t __attribute__((ext_vector_type(4)));
    return __builtin_bit_cast(s16x4, __builtin_amdgcn_ds_read_tr16_b64_v4i16((LAS v4i16_t*)p)); }
__device__ __forceinline__ void attn_unit(const bf16* __restrict__ Q, const bf16* __restrict__ K, const bf16* __restrict__ V, const bf16* __restrict__ ZA, bf16* __restrict__ Y,
                                          int b, int h, int qt, LAS unsigned char* vl, int lane) {
    const int j = lane & 31, hi = lane >> 5;
    const size_t row0 = (size_t)b * SEQ + (size_t)qt * 32;
    const bf16* qp = Q + (row0 + j) * 512 + h * 64 + 8 * hi;
    bf16x8 qf[4];
#pragma unroll
    for (int s = 0; s < 4; ++s) qf[s] = *(const bf16x8*)(qp + 16 * s);
    f32x16 o0, o1;
#pragma unroll
    for (int r = 0; r < 16; ++r) { o0[r] = 0.f; o1[r] = 0.f; }
    float carry = 0.f;
    const int blk = (lane >> 4) & 1, q4 = (lane & 15) >> 2, p4 = lane & 3;
    const unsigned trb = (unsigned)((4 * hi + q4) * VPITCH + (16 * blk + 4 * p4) * 2);
    const unsigned vwb = (unsigned)((lane >> 3) * VPITCH + (lane & 7) * 16);
    for (int kt = qt; kt >= 0; --kt) {
        const size_t krow0 = (size_t)b * SEQ + (size_t)kt * 32;
        const bf16* kp = K + (krow0 + j) * 512 + h * 64 + 8 * hi;
        bf16x8 kf[4];
#pragma unroll
        for (int s = 0; s < 4; ++s) kf[s] = *(const bf16x8*)(kp + 16 * s);
        const bf16* vp = V + (krow0 + (lane >> 3)) * 512 + h * 64 + (lane & 7) * 8;
        v4u vv[4];
#pragma unroll
        for (int i = 0; i < 4; ++i) vv[i] = *(const v4u*)(vp + (size_t)i * 8 * 512);
        f32x16 sc;
#pragma unroll
        for (int r = 0; r < 16; ++r) sc[r] = 0.f;
#pragma unroll
        for (int s = 0; s < 4; ++s) sc = __builtin_amdgcn_mfma_f32_32x32x16_bf16(kf[s], qf[s], sc, 0, 0, 0);
        asm volatile("" ::: "memory");
#pragma unroll
        for (int i = 0; i < 4; ++i) *(LAS v4u*)(vl + vwb + i * 8 * VPITCH) = vv[i];
        asm volatile("" ::: "memory");
        const bool diag = (kt == qt);
        float sp[16];
#pragma unroll
        for (int r = 0; r < 16; ++r) { const float z = sc[r]; const float e = __builtin_amdgcn_exp2f(-__builtin_fabsf(z));
            float x = __builtin_fmaxf(z, 0.f) + __builtin_amdgcn_logf(1.0f + e);
            if (diag && crow(r, hi) >= j) x = 0.f; sp[r] = x; }
        float R[4], Rp[4], Tt[4];
#pragma unroll
        for (int a = 0; a < 4; ++a) { R[a] = (sp[4 * a] + sp[4 * a + 1]) + (sp[4 * a + 2] + sp[4 * a + 3]); Rp[a] = __shfl_xor(R[a], 32); Tt[a] = R[a] + Rp[a]; }
        float suf = carry; float w[16];
#pragma unroll
        for (int a = 3; a >= 0; --a) { const float base = suf + (hi == 0 ? Rp[a] : 0.f);
            const float c3 = base + sp[4 * a + 3], c2 = c3 + sp[4 * a + 2], c1 = c2 + sp[4 * a + 1], c0 = c1 + sp[4 * a];
            w[4 * a + 3] = __builtin_amdgcn_exp2f(sc[4 * a + 3] - c3); w[4 * a + 2] = __builtin_amdgcn_exp2f(sc[4 * a + 2] - c2);
            w[4 * a + 1] = __builtin_amdgcn_exp2f(sc[4 * a + 1] - c1); w[4 * a] = __builtin_amdgcn_exp2f(sc[4 * a] - c0);
            suf += Tt[a]; }
        carry = suf;
        if (diag) {
#pragma unroll
            for (int r = 0; r < 16; ++r) if (crow(r, hi) >= j) w[r] = 0.f; }
        bf16x8 pf[2];
#pragma unroll
        for (int s = 0; s < 2; ++s) { v4u p; p.x = cvtpk(w[8 * s], w[8 * s + 1]); p.y = cvtpk(w[8 * s + 2], w[8 * s + 3]); p.z = cvtpk(w[8 * s + 4], w[8 * s + 5]); p.w = cvtpk(w[8 * s + 6], w[8 * s + 7]);
            pf[s] = __builtin_bit_cast(bf16x8, p); }
#pragma unroll
        for (int s = 0; s < 2; ++s) {
            { const s16x4 lo = vtr(vl + trb + (16 * s) * VPITCH), hh = vtr(vl + trb + (16 * s + 8) * VPITCH);
              const bf16x8 vf = (bf16x8){lo[0], lo[1], lo[2], lo[3], hh[0], hh[1], hh[2], hh[3]};
              o0 = __builtin_amdgcn_mfma_f32_32x32x16_bf16(vf, pf[s], o0, 0, 0, 0); }
            { const s16x4 lo = vtr(vl + trb + (16 * s) * VPITCH + 64), hh = vtr(vl + trb + (16 * s + 8) * VPITCH + 64);
              const bf16x8 vf = (bf16x8){lo[0], lo[1], lo[2], lo[3], hh[0], hh[1], hh[2], hh[3]};
              o1 = __builtin_amdgcn_mfma_f32_32x32x16_bf16(vf, pf[s], o1, 0, 0, 0); }
        }
        asm volatile("" ::: "memory");
        if (__ballot(carry < SB_EXIT) == 0ull) break;
    }
    const size_t zrow = (row0 + j) * 512 + h * 64, yrow = (row0 + j) * 1024 + 512 + h * 64;
#pragma unroll
    for (int a = 0; a < 4; ++a) { const int d0 = 8 * a + 4 * hi;
        { const v2u zz = *(const v2u*)(ZA + zrow + d0); v2u o; o.x = cvtpk(o0[4 * a] * bflo(zz.x), o0[4 * a + 1] * bfhi(zz.x)); o.y = cvtpk(o0[4 * a + 2] * bflo(zz.y), o0[4 * a + 3] * bfhi(zz.y));
          *(v2u*)(Y + yrow + d0) = o; }
        { const v2u zz = *(const v2u*)(ZA + zrow + 32 + d0); v2u o; o.x = cvtpk(o1[4 * a] * bflo(zz.x), o1[4 * a + 1] * bfhi(zz.x)); o.y = cvtpk(o1[4 * a + 2] * bflo(zz.y), o1[4 * a + 3] * bfhi(zz.y));
          *(v2u*)(Y + yrow + 32 + d0) = o; } }
}

__device__ __forceinline__ void unpack8(const v4u q, float (&f)[8]) { f[0] = bflo(q.x); f[1] = bfhi(q.x); f[2] = bflo(q.y); f[3] = bfhi(q.y); f[4] = bflo(q.z); f[5] = bfhi(q.z); f[6] = bflo(q.w); f[7] = bfhi(q.w); }
__device__ __forceinline__ void pool_task(const bf16* __restrict__ VP, const bf16* __restrict__ ZP, bf16* __restrict__ Y, int task) {
    const int chunk = task & 63, tb = task >> 6, g = chunk >> 4, w = 2 << g;
    const int t0 = tb * 64, pos0 = t0 & (SEQ - 1);
    const bf16* vp = VP + (size_t)t0 * 512 + chunk * 8; const bf16* zp = ZP + (size_t)t0 * 512 + chunk * 8; bf16* yp = Y + (size_t)t0 * 1024 + chunk * 8;
    float s[8];
#pragma unroll
    for (int e = 0; e < 8; ++e) s[e] = 0.f;
    for (int jj = 1; jj < w; ++jj) if (pos0 - jj >= 0) { float f[8]; unpack8(*(const v4u*)(vp - (ptrdiff_t)jj * 512), f);
#pragma unroll
        for (int e = 0; e < 8; ++e) s[e] += f[e]; }
#pragma unroll 4
    for (int t = 0; t < 64; ++t) { const int pos = pos0 + t;
        float v[8], z[8]; unpack8(*(const v4u*)(vp + (size_t)t * 512), v); unpack8(*(const v4u*)(zp + (size_t)t * 512), z);
        const float inv = 1.0f / (float)(pos + 1 < w ? pos + 1 : w);
        float y[8];
#pragma unroll
        for (int e = 0; e < 8; ++e) { s[e] += v[e]; y[e] = (s[e] * inv - v[e]) * z[e]; }
        v4u o; o.x = cvtpk(y[0], y[1]); o.y = cvtpk(y[2], y[3]); o.z = cvtpk(y[4], y[5]); o.w = cvtpk(y[6], y[7]);
        *(v4u*)(yp + (size_t)t * 1024) = o;
        if (pos + 1 >= w) { float f[8]; unpack8(*(const v4u*)(vp + (ptrdiff_t)(t + 1 - w) * 512), f);
#pragma unroll
            for (int e = 0; e < 8; ++e) s[e] -= f[e]; }
    }
}

struct Args { const float* in[10]; float* out; unsigned char* ws; };
__global__ void __launch_bounds__(NTHREADS, 2) fwd_megakernel(Args args) {
    extern __shared__ __attribute__((aligned(16))) unsigned char lds_raw[];
    LAS unsigned char* lds = (LAS unsigned char*)lds_raw;
    cg::grid_group grid = cg::this_grid();
    const int tid = threadIdx.x, lane = tid & 63, wave = __builtin_amdgcn_readfirstlane(tid >> 6);
    const int G = gridDim.x, bx = blockIdx.x, vcu = (G % 8 == 0) ? (bx % 8) * (G / 8) + bx / 8 : bx;
    const int gw = vcu * NWAVES + wave, NGW = G * NWAVES;
    const float* x = args.in[0]; const float* norm_g = args.in[1]; const float* w_in = args.in[2]; const float* b_gate = args.in[3]; const float* pool_w = args.in[4];
    const float* pool_scale = args.in[5]; const float* w_pool_up = args.in[6]; const float* w_attn_up = args.in[7]; const float* w_out = args.in[8]; const float* final_g = args.in[9];
    float* out = args.out; unsigned char* ws = args.ws;
    float* SSP = (float*)(ws + WS_SSP);
    bf16* XG = (bf16*)(ws + WS_XG); bf16* VP = (bf16*)(ws + WS_VP); bf16* ZP = (bf16*)(ws + WS_ZP); bf16* Qb = (bf16*)(ws + WS_Q); bf16* Kb = (bf16*)(ws + WS_K);
    bf16* Vb = (bf16*)(ws + WS_V); bf16* ZA = (bf16*)(ws + WS_ZA); bf16* Gt = (bf16*)(ws + WS_G); bf16* Yb = (bf16*)(ws + WS_Y); bf16* MG = (bf16*)(ws + WS_MG);

    {
        LAS float* PW = (LAS float*)lds; LAS float* WI = (LAS float*)(lds + 65536);
        for (int it = vcu; it < 256; it += G) {
            const int l = it >> 7, g = (it >> 5) & 3, k0 = (it & 31) * 32;
            const float* pw = pool_w + ((size_t)l * 4 + g) * 16384; const float* wi = w_in + (size_t)l * DM * NIN + (size_t)k0 * NIN + g * 128;
            __syncthreads();
#pragma unroll 4
            for (int i = 0; i < 32; ++i) PW[tid + 512 * i] = pw[tid + 512 * i];
#pragma unroll
            for (int i = 0; i < 8; ++i) { const int idx = tid + 512 * i; WI[idx] = wi[(size_t)(idx >> 7) * NIN + (idx & 127)]; }
            __syncthreads();
            const int d = tid & 127, kq = tid >> 7; float acc[8];
#pragma unroll
            for (int e = 0; e < 8; ++e) acc[e] = 0.f;
            for (int c = 0; c < 128; ++c) { const float p = PW[c * 128 + d];
#pragma unroll
                for (int e = 0; e < 8; ++e) acc[e] += WI[(kq * 8 + e) * 128 + c] * p; }
            const float sc = pool_scale[l * 512 + g * 128 + d];
            v4u o; o.x = pk2(acc[0] * sc, acc[1] * sc); o.y = pk2(acc[2] * sc, acc[3] * sc); o.z = pk2(acc[4] * sc, acc[5] * sc); o.w = pk2(acc[6] * sc, acc[7] * sc);
            bf16* wt = (bf16*)(ws + WS_W + (size_t)l * W_LAYER);
            *(v4u*)(wt + (size_t)(g * 128 + d) * 1024 + k0 + kq * 8) = o;
        }
        __syncthreads();
        LAS float* scr = (LAS float*)(lds + wave * 16384);
        for (int it = gw; it < 6656; it += NGW) {
            const int l = it / 3328; int r = it % 3328;
            bf16* win_t = (bf16*)(ws + WS_W + (size_t)l * W_LAYER); bf16* wpa_t = win_t + (size_t)NIN * 1024; bf16* wout_t = wpa_t + (size_t)1024 * 1024;
            if (r < 2304) { const int kb = r / 144, nb = r % 144; tr_item(w_in + (size_t)l * DM * NIN, NIN, win_t, 1024, kb * 64, 512 + nb * 32, 512 + nb * 32, kb * 64, scr, lane); continue; } r -= 2304;
            if (r < 256) { const int kb = r / 32, nb = r % 32; tr_item(w_pool_up + (size_t)l * 512 * 1024, 1024, wpa_t, 1024, kb * 64, nb * 32, nb * 32, kb * 64, scr, lane); continue; } r -= 256;
            if (r < 256) { const int kb = r / 32, nb = r % 32; tr_item(w_attn_up + (size_t)l * 512 * 1024, 1024, wpa_t, 1024, kb * 64, nb * 32, nb * 32, 512 + kb * 64, scr, lane); continue; } r -= 256;
            { const int kb = r / 32, nb = r % 32; tr_item(w_out + (size_t)l * 1024 * 1024, 1024, wout_t, 1024, kb * 64, nb * 32, nb * 32, kb * 64, scr, lane); }
        }
        for (int m = gw; m < T; m += NGW) {
            const f32x4* xr = (const f32x4*)(x + (size_t)m * DM) + lane; const f32x4* gr = (const f32x4*)norm_g + lane;
            f32x4 v[4]; float s = 0.f;
#pragma unroll
            for (int jx = 0; jx < 4; ++jx) { v[jx] = xr[64 * jx]; s += (v[jx][0] * v[jx][0] + v[jx][1] * v[jx][1]) + (v[jx][2] * v[jx][2] + v[jx][3] * v[jx][3]); }
            s = wave_sum(s);
            v2u* o8 = (v2u*)(XG + (size_t)m * DM) + lane;
#pragma unroll
            for (int jx = 0; jx < 4; ++jx) { const f32x4 gg = gr[64 * jx]; v2u o; o.x = pk2(v[jx][0] * gg[0], v[jx][1] * gg[1]); o.y = pk2(v[jx][2] * gg[2], v[jx][3] * gg[3]); o8[64 * jx] = o; }
            if (lane < 16) SSP[(size_t)m * 16 + lane] = (lane == 0) ? s : 0.f;
        }
    }
    grid.sync();

    for (int l = 0; l < 2; ++l) {
        const bf16* win_t = (const bf16*)(ws + WS_W + (size_t)l * W_LAYER); const bf16* wpa_t = win_t + (size_t)NIN * 1024; const bf16* wout_t = wpa_t + (size_t)1024 * 1024;
        {   pg8::Gemm g{XG, win_t, T, NIN, DM, DM, DM}; pg8::StaticOrder S; S.init(T, NIN, G, bx);
            pg8::EpiProj E{VP, ZP, Qb, Kb, Vb, ZA, Gt, SSP, b_gate + l * 2048};
            pg8::gemm_phase<pg8::EpiProj, pg8::StaticOrder, true, true>(lds, g, S, E); }
        grid.sync();
        {   LAS unsigned char* vl = lds + wave * 8192;
            for (int u = gw; u < NB * NH * (SEQ / 32); u += NGW) { const int qt = u & 255, bh = u >> 8; attn_unit(Qb, Kb, Vb, ZA, Yb, bh >> 3, bh & 7, qt, vl, lane); }
            for (int task = vcu * NTHREADS + tid; task < (T / 64) * 64; task += G * NTHREADS) pool_task(VP, ZP, Yb, task); }
        grid.sync();
        {   pg8::StaticOrder S; S.init(T, DM, G, bx);
            { pg8::Gemm g{Yb, wpa_t, T, DM, 512, 1024, 1024}; pg8::EpiMerge<0> E{MG, Gt}; pg8::gemm_phase<pg8::EpiMerge<0>, pg8::StaticOrder, true, true>(lds, g, S, E); }
            { pg8::Gemm g{Yb + 512, wpa_t + 512, T, DM, 512, 1024, 1024}; pg8::EpiMerge<1> E{MG, Gt}; pg8::gemm_phase<pg8::EpiMerge<1>, pg8::StaticOrder, true, true>(lds, g, S, E); } }
        grid.sync();
        {   pg8::Gemm g{MG, wout_t, T, DM, DM, DM, DM}; pg8::StaticOrder S; S.init(T, DM, G, bx);
            pg8::EpiOut E{l == 0 ? x : (const float*)out, out, XG, norm_g + 1024, SSP, l == 0 ? 1 : 0};
            pg8::gemm_phase<pg8::EpiOut, pg8::StaticOrder, true, true>(lds, g, S, E); }
        grid.sync();
    }
    for (int m = gw; m < T; m += NGW) {
        float ss = SSP[(size_t)m * 16 + (lane & 15)];
        ss += __shfl_xor(ss, 1); ss += __shfl_xor(ss, 2); ss += __shfl_xor(ss, 4); ss += __shfl_xor(ss, 8);
        const float rstd = __builtin_amdgcn_rsqf(ss * (1.0f / 1024.0f) + 1e-6f);
        f32x4* xr = (f32x4*)(out + (size_t)m * DM) + lane; const f32x4* gr = (const f32x4*)final_g + lane;
#pragma unroll
        for (int jx = 0; jx < 4; ++jx) { const f32x4 v = xr[64 * jx]; xr[64 * jx] = v * rstd * gr[64 * jx]; }
    }
}

extern "C" void kernel_launch(void* const* d_in, const int* in_sizes, int n_in, void* d_out, int out_size, void* d_ws, size_t ws_size, hipStream_t stream) {
    static int grid = 0;
    if (grid == 0) {
        if (n_in != 10 || in_sizes[0] != T * DM || out_size != T * DM || ws_size < WS_END) { fprintf(stderr, "kernel_launch: unexpected shapes / workspace (ws %zu, need %zu)\n", ws_size, (size_t)WS_END); grid = -1; return; }
        int dev = 0, cus = 0, per_cu = 0;
        hipGetDevice(&dev); hipDeviceGetAttribute(&cus, hipDeviceAttributeMultiprocessorCount, dev);
        hipFuncSetAttribute((const void*)fwd_megakernel, hipFuncAttributeMaxDynamicSharedMemorySize, LDS_BYTES);
        hipOccupancyMaxActiveBlocksPerMultiprocessor(&per_cu, (const void*)fwd_megakernel, NTHREADS, LDS_BYTES);
        if (per_cu < 1) { fprintf(stderr, "kernel_launch: occupancy query says %d blocks per CU\n", per_cu); per_cu = 1; }
        grid = cus * per_cu;
    }
    if (grid < 0) return;
    Args a{};
    for (int i = 0; i < 10; ++i) a.in[i] = (const float*)d_in[i];
    a.out = (float*)d_out; a.ws = (unsigned char*)d_ws;
    void* kargs[] = {&a};
    hipError_t e = hipLaunchCooperativeKernel((const void*)fwd_megakernel, dim3(grid), dim3(NTHREADS), kargs, LDS_BYTES, stream);
    if (e != hipSuccess) fprintf(stderr, "cooperative launch failed: %s (grid %d)\n", hipGetErrorString(e), grid);
}
```

```cpp
#include <hip/hip_runtime.h>
#include <hip/hip_cooperative_groups.h>
#include <cstdio>
#include <cstdint>
namespace cg = cooperative_groups;
namespace pg8 {
#define PG8_LAS __attribute__((address_space(3)))
typedef unsigned short bf16_t;
typedef short bf16x8 __attribute__((ext_vector_type(8)));
typedef float f32x4 __attribute__((ext_vector_type(4)));
typedef unsigned u32x4 __attribute__((ext_vector_type(4)));
constexpr int BM = 256, BK = 64, HALF = 128, HTB = HALF * BK * 2  , STAGE_BYTES = 8 * HTB, NXCD = 8, WGM = 8;

__host__ __device__ __forceinline__ int lds_byte(int r, int c) { const int st = (r >> 4) * 2 + (c >> 5), rr = r & 15, cc = c & 31, ob = rr * 64 + cc * 2; return st * 1024 + (ob ^ (((ob >> 9) & 1) << 5)); }
__host__ __device__ __forceinline__ void stage_rc(int b, int& R, int& C) { const int st = b / 1024, sb = b % 1024, swz = sb ^ (((sb >> 9) & 1) << 5); R = (st >> 1) * 16 + swz / 64; C = (st & 1) * 32 + (swz % 64) / 2; }
__host__ __device__ __forceinline__ int perm32(int rho) { const int n = rho >> 4, i = rho & 15; return 8 * (i >> 2) + 4 * n + (i & 3); }

struct Unit { int pm, pn; };
struct Gemm { const bf16_t* A; const bf16_t* Bt; int M, N, K, lda, ldb; };

struct StaticOrder {
    int nM, nN, nwg, G, c;
    __host__ __device__ void init(int M, int N, int G_, int c_) { nM = M / BM; nN = N / BM; nwg = nM * nN; G = G_; c = c_; }
    __host__ __device__ bool next(int i, Unit& u) const {
        const long L = (long)i * G + c; if (L >= nwg) return false;
        int wgid = (int)L; { const int q = nwg / NXCD, r = nwg % NXCD, xcd = wgid % NXCD, off = wgid / NXCD; wgid = (xcd < r ? xcd * (q + 1) : r * (q + 1) + (xcd - r) * q) + off; }
        const int nig = WGM * nN, gid = wgid / nig, fm = gid * WGM, gsz = (nM - fm) < WGM ? (nM - fm) : WGM;
        u.pm = fm + ((wgid % nig) % gsz); u.pn = (wgid % nig) / gsz; return true;
    }
    __device__ __forceinline__ void a_ready(const Unit&) const {}
    __device__ __forceinline__ void done(const Unit&) const {}
};

__device__ __forceinline__ unsigned cvt_pk_bf16(float lo, float hi) { unsigned r; asm volatile("v_cvt_pk_bf16_f32 %0, %1, %2" : "=v"(r) : "v"(lo), "v"(hi)); return r; }
typedef float f32x2 __attribute__((ext_vector_type(2)));
__device__ __forceinline__ float bf_lo(unsigned u) { return __uint_as_float(u << 16); }
__device__ __forceinline__ float bf_hi(unsigned u) { return __uint_as_float(u & 0xffff0000u); }
__device__ __forceinline__ float sigmoid_f(float v) { return __builtin_amdgcn_rcpf(1.0f + __builtin_amdgcn_exp2f(-1.4426950408889634f * v)); }
constexpr float RMS_EPS_F = 1e-6f;
constexpr float QSCALE = 0.125f * 1.4426950408889634f;

struct EpiProj {
    static constexpr bool PERM = true, AFTER_DRAIN = false;
    bf16_t *VP, *ZP, *Q, *K, *V, *ZA, *G; const float* ssp; const float* bgate;
    __device__ __forceinline__ void operator()(const f32x4 (&acc)[2][2][4][2], const Unit& u, int wr, int wc, int fr, int fq) const {
        const int pn = u.pn; bf16_t* base; int ld, mode, colt; float sc = 1.f;
        if (pn < 12) { const int seg = pn >> 1; colt = (pn & 1) * 256; ld = 512;
            base = seg == 0 ? VP : seg == 1 ? ZP : seg == 2 ? Q : seg == 3 ? K : seg == 4 ? V : ZA;
            mode = (seg == 1 || seg == 5) ? 1 : 0; if (seg == 2) sc = QSCALE; }
        else { base = G; colt = (pn - 12) * 256; ld = 2048; mode = 2; }
        const int row0 = u.pm * BM + wr * 64 + fr, col0 = colt + wc * 32 + 8 * fq;
        f32x4 bv[2][2];
#pragma unroll
        for (int bj = 0; bj < 2; ++bj)
#pragma unroll
            for (int n = 0; n < 2; ++n) bv[bj][n] = (mode == 2) ? *(const f32x4*)(bgate + col0 + bj * HALF + 4 * n) : (f32x4){0.f, 0.f, 0.f, 0.f};
#pragma unroll
        for (int ai = 0; ai < 2; ++ai)
#pragma unroll
            for (int m = 0; m < 4; ++m) { const int row = row0 + ai * HALF + m * 16;
                const f32x4* sp = (const f32x4*)(ssp + (size_t)row * 16); const f32x4 s0 = sp[0], s1 = sp[1], s2 = sp[2], s3 = sp[3];
                const f32x4 st = (s0 + s1) + (s2 + s3); const float ss = (st[0] + st[1]) + (st[2] + st[3]);
                const float rstd = __builtin_amdgcn_rsqf(ss * (1.0f / 1024.0f) + RMS_EPS_F) * sc;
                bf16_t* rowp = base + (size_t)row * ld + col0;
#pragma unroll
                for (int bj = 0; bj < 2; ++bj) { f32x4 v0 = acc[ai][bj][m][0] * rstd, v1 = acc[ai][bj][m][1] * rstd;
                    if (mode == 2) { v0 = v0 + bv[bj][0]; v1 = v1 + bv[bj][1];
#pragma unroll
                        for (int e = 0; e < 4; ++e) { v0[e] = sigmoid_f(v0[e]); v1[e] = sigmoid_f(v1[e]); } }
                    else if (mode == 1) {
#pragma unroll
                        for (int e = 0; e < 4; ++e) { v0[e] = v0[e] * sigmoid_f(v0[e]); v1[e] = v1[e] * sigmoid_f(v1[e]); } }
                    u32x4 w; w.x = cvt_pk_bf16(v0[0], v0[1]); w.y = cvt_pk_bf16(v0[2], v0[3]); w.z = cvt_pk_bf16(v1[0], v1[1]); w.w = cvt_pk_bf16(v1[2], v1[3]);
                    *(u32x4*)(rowp + bj * HALF) = w; } }
    }
};
template <int PASS> struct EpiMerge {
    static constexpr bool PERM = true, AFTER_DRAIN = false;
    bf16_t* MG; const bf16_t* G;
    __device__ __forceinline__ void operator()(const f32x4 (&acc)[2][2][4][2], const Unit& u, int wr, int wc, int fr, int fq) const {
        const int row0 = u.pm * BM + wr * 64 + fr, col0 = u.pn * BM + wc * 32 + 8 * fq;
#pragma unroll
        for (int ai = 0; ai < 2; ++ai)
#pragma unroll
            for (int m = 0; m < 4; ++m) { const int row = row0 + ai * HALF + m * 16;
#pragma unroll
                for (int bj = 0; bj < 2; ++bj) { const int col = col0 + bj * HALF;
                    const u32x4 gq = *(const u32x4*)(G + (size_t)row * 2048 + PASS * 1024 + col);
                    f32x4 v0 = acc[ai][bj][m][0], v1 = acc[ai][bj][m][1];
                    v0[0] *= bf_lo(gq.x); v0[1] *= bf_hi(gq.x); v0[2] *= bf_lo(gq.y); v0[3] *= bf_hi(gq.y);
                    v1[0] *= bf_lo(gq.z); v1[1] *= bf_hi(gq.z); v1[2] *= bf_lo(gq.w); v1[3] *= bf_hi(gq.w);
                    u32x4* mp = (u32x4*)(MG + (size_t)row * 1024 + col);
                    if (PASS == 1) { const u32x4 pq = *mp;
                        v0[0] += bf_lo(pq.x); v0[1] += bf_hi(pq.x); v0[2] += bf_lo(pq.y); v0[3] += bf_hi(pq.y);
                        v1[0] += bf_lo(pq.z); v1[1] += bf_hi(pq.z); v1[2] += bf_lo(pq.w); v1[3] += bf_hi(pq.w); }
                    u32x4 w; w.x = cvt_pk_bf16(v0[0], v0[1]); w.y = cvt_pk_bf16(v0[2], v0[3]); w.z = cvt_pk_bf16(v1[0], v1[1]); w.w = cvt_pk_bf16(v1[2], v1[3]);
                    *mp = w; } }
    }
};
struct EpiOut {
    static constexpr bool PERM = false, AFTER_DRAIN = false;
    const float* xin; float* xout; bf16_t* XG; const float* gnext; float* ssp; int write_xg;
    __device__ __forceinline__ void operator()(const f32x4 (&acc)[2][2][4][2], const Unit& u, int wr, int wc, int fr, int fq) const {
        typedef unsigned u32x2v __attribute__((ext_vector_type(2)));
        const int col0 = u.pn * BM + wc * 32 + 4 * fq;
#pragma unroll
        for (int ai = 0; ai < 2; ++ai)
#pragma unroll
            for (int m = 0; m < 4; ++m) { const int row = u.pm * BM + ai * HALF + wr * 64 + m * 16 + fr; const size_t off = (size_t)row * 1024 + col0; float ss = 0.f;
#pragma unroll
                for (int bj = 0; bj < 2; ++bj)
#pragma unroll
                    for (int n = 0; n < 2; ++n) { const int co = bj * HALF + n * 16;
                        const f32x4 v = *(const f32x4*)(xin + off + co) + acc[ai][bj][m][n];
                        *(f32x4*)(xout + off + co) = v; ss += (v[0] * v[0] + v[1] * v[1]) + (v[2] * v[2] + v[3] * v[3]);
                        if (write_xg) { const f32x4 gg = *(const f32x4*)(gnext + col0 + co); u32x2v w; w.x = cvt_pk_bf16(v[0] * gg[0], v[1] * gg[1]); w.y = cvt_pk_bf16(v[2] * gg[2], v[3] * gg[3]);
                            *(u32x2v*)(XG + off + co) = w; } }
                ss += __shfl_xor(ss, 16); ss += __shfl_xor(ss, 32);
                if (fq == 0) ssp[(size_t)row * 16 + u.pn * 4 + wc] = ss; }
    }
};
template <class Epi, class Sched, bool ALIGN_EPI = false, bool SP2 = false>
__device__ __forceinline__ void gemm_phase(PG8_LAS unsigned char* lds, const Gemm g_in, const Sched& S, const Epi& E) {
    Gemm g = g_in; asm volatile("" : "+s"(g.A), "+s"(g.Bt));
    int tid_ = threadIdx.x; asm volatile("" : "+v"(tid_));
    const int tid = tid_, wid = __builtin_amdgcn_readfirstlane(tid >> 6), lane = tid & 63, wr = wid >> 2, wc = wid & 3, fr = lane & 15, fq = lane >> 4;
    const int K = g.K, nt = K / BK;
    unsigned voffA[2], voffB[2];
#pragma unroll
    for (int i = 0; i < 2; ++i) { int R, C; stage_rc(tid * 16 + i * 8192, R, C); const int Rb = Epi::PERM ? ((R & ~31) + perm32(R & 31)) : R;
        voffA[i] = (unsigned)(R * g.lda + C) * 2u; voffB[i] = (unsigned)(Rb * g.ldb + C) * 2u; }
    const size_t kstep = (size_t)(BK * 2);
    const size_t hstepA = (size_t)HALF * g.lda * 2, hstepB = (size_t)HALF * g.ldb * 2;
    const size_t tstepA = 2 * hstepA, tstepB = 2 * hstepB;
    const unsigned ldsw = (unsigned)wid * 1024u;
    const int aoff = lds_byte(wr * 64 + fr, fq * 8), boff = lds_byte(wc * 32 + fr, fq * 8);
#define PG8_SA(b, h) (((b) * 2 + (h)) * HTB)
#define PG8_SB(b, h) ((4 + (b) * 2 + (h)) * HTB)
#define PG8_STAGE(bufoff, gbase, voff) do { _Pragma("unroll") for (int _i = 0; _i < 2; ++_i) \
        __builtin_amdgcn_global_load_lds((const unsigned*)((const char*)(gbase) + (voff)[_i]), (PG8_LAS unsigned*)(lds + (bufoff) + ldsw + _i * 8192), 16, 0, 0); } while (0)
#define PG8_LDA(dst, b, h) do { _Pragma("unroll") for (int m = 0; m < 4; ++m) _Pragma("unroll") for (int k = 0; k < 2; ++k) dst[m][k] = *(const PG8_LAS bf16x8*)(lds + PG8_SA(b, h) + aoff + m * 2048 + k * 1024); } while (0)
#define PG8_LDB(dst, b, h) do { _Pragma("unroll") for (int n = 0; n < 2; ++n) _Pragma("unroll") for (int k = 0; k < 2; ++k) dst[n][k] = *(const PG8_LAS bf16x8*)(lds + PG8_SB(b, h) + boff + n * 2048 + k * 1024); } while (0)
#define PG8_MMA(ai, bj, At, Bt) do { __builtin_amdgcn_s_setprio(1); _Pragma("unroll") for (int m = 0; m < 4; ++m) _Pragma("unroll") for (int n = 0; n < 2; ++n) _Pragma("unroll") for (int k = 0; k < 2; ++k) \
        acc[ai][bj][m][n] = __builtin_amdgcn_mfma_f32_16x16x32_bf16(Bt[n][k], At[m][k], acc[ai][bj][m][n], 0, 0, 0); __builtin_amdgcn_s_setprio(0); } while (0)
#define PG8_WAIT_V(n) asm volatile("s_waitcnt vmcnt(" #n ")" ::: "memory")
#define PG8_WAIT_L(n) asm volatile("s_waitcnt lgkmcnt(" #n ")" ::: "memory")
#define PG8_BAR __builtin_amdgcn_s_barrier()
#define PG8_SCHED __builtin_amdgcn_sched_barrier(0)
    Unit cur, nxt; int ui = 0;
    if (!S.next(0, cur)) return;
    f32x4 acc[2][2][4][2];
#pragma unroll
    for (int a = 0; a < 2; ++a)
#pragma unroll
        for (int b = 0; b < 2; ++b)
#pragma unroll
            for (int m = 0; m < 4; ++m)
#pragma unroll
                for (int n = 0; n < 2; ++n) acc[a][b][m][n] = (f32x4){0.f, 0.f, 0.f, 0.f};
    bf16x8 At[4][2], B0[2][2], B1[2][2];
    const char* cA = (const char*)g.A + (size_t)cur.pm * tstepA; const char* cB = (const char*)g.Bt + (size_t)cur.pn * tstepB;
    S.a_ready(cur);
    if constexpr (SP2) {
        PG8_STAGE(PG8_SB(0, 0), cB, voffB); PG8_STAGE(PG8_SB(0, 1), cB + hstepB, voffB); PG8_STAGE(PG8_SA(0, 0), cA, voffA); PG8_STAGE(PG8_SA(0, 1), cA + hstepA, voffA);
        if (wr == 1) PG8_BAR;
        PG8_WAIT_V(2); PG8_BAR;
        PG8_STAGE(PG8_SB(1, 0), cB + kstep, voffB); PG8_STAGE(PG8_SA(1, 0), cA + kstep, voffA); PG8_STAGE(PG8_SB(1, 1), cB + hstepB + kstep, voffB);
        PG8_WAIT_V(6); PG8_BAR;
    } else {
        PG8_STAGE(PG8_SB(0, 0), cB, voffB); PG8_STAGE(PG8_SA(0, 0), cA, voffA); PG8_STAGE(PG8_SB(0, 1), cB + hstepB, voffB); PG8_STAGE(PG8_SA(0, 1), cA + hstepA, voffA);
        if (wr == 1) PG8_BAR;
        PG8_WAIT_V(4); PG8_BAR;
        PG8_STAGE(PG8_SB(1, 0), cB + kstep, voffB); PG8_STAGE(PG8_SA(1, 0), cA + kstep, voffA); PG8_STAGE(PG8_SB(1, 1), cB + hstepB + kstep, voffB);
        PG8_WAIT_V(6); PG8_BAR;
    }
    for (;;) {
        const bool has_next = S.next(ui + 1, nxt);
        const char* nA = has_next ? (const char*)g.A + (size_t)nxt.pm * tstepA : cA; const char* nB = has_next ? (const char*)g.Bt + (size_t)nxt.pn * tstepB : cB;
        for (int t = 0; t < nt; t += 2) {
            const bool last = (t == nt - 2);
            const char* a1 = cA + (size_t)(t + 1) * kstep;
            const char* a2 = last ? nA : cA + (size_t)(t + 2) * kstep; const char* b2 = last ? nB : cB + (size_t)(t + 2) * kstep;
            const char* a3 = a2 + kstep; const char* b3 = b2 + kstep;
            if (last && has_next) S.a_ready(nxt);
            if constexpr (SP2) {
            PG8_LDB(B0, 0, 0); PG8_LDB(B1, 0, 1); PG8_SCHED; PG8_LDA(At, 0, 0); PG8_STAGE(PG8_SA(1, 1), a1 + hstepA, voffA);
            PG8_WAIT_V(8); PG8_WAIT_L(0); PG8_BAR; PG8_MMA(0, 0, At, B0); PG8_MMA(0, 1, At, B1); PG8_BAR; PG8_SCHED;
            PG8_LDA(At, 0, 1); PG8_STAGE(PG8_SB(0, 0), b2, voffB); PG8_STAGE(PG8_SB(0, 1), b2 + hstepB, voffB); PG8_STAGE(PG8_SA(0, 0), a2, voffA);
            PG8_WAIT_V(8); PG8_WAIT_L(0); PG8_BAR; PG8_MMA(1, 0, At, B0); PG8_MMA(1, 1, At, B1); PG8_BAR; PG8_SCHED;
            PG8_LDB(B0, 1, 0); PG8_LDB(B1, 1, 1); PG8_SCHED; PG8_LDA(At, 1, 0); PG8_STAGE(PG8_SA(0, 1), a2 + hstepA, voffA);
            PG8_WAIT_V(8); PG8_WAIT_L(0); PG8_BAR; PG8_MMA(0, 0, At, B0); PG8_MMA(0, 1, At, B1); PG8_BAR; PG8_SCHED;
            PG8_LDA(At, 1, 1); PG8_STAGE(PG8_SB(1, 0), b3, voffB); PG8_STAGE(PG8_SB(1, 1), b3 + hstepB, voffB); PG8_STAGE(PG8_SA(1, 0), a3, voffA);
            PG8_WAIT_V(8); PG8_WAIT_L(0); PG8_BAR; PG8_MMA(1, 0, At, B0); PG8_MMA(1, 1, At, B1); PG8_BAR; PG8_SCHED;
            } else {
            PG8_LDB(B0, 0, 0); PG8_SCHED; PG8_LDA(At, 0, 0); PG8_STAGE(PG8_SA(1, 1), a1 + hstepA, voffA);
            PG8_WAIT_L(8); PG8_BAR; PG8_WAIT_L(0); PG8_MMA(0, 0, At, B0); PG8_BAR; PG8_SCHED;
            PG8_LDB(B1, 0, 1); PG8_STAGE(PG8_SB(0, 0), b2, voffB);
            PG8_BAR; PG8_WAIT_L(0); PG8_MMA(0, 1, At, B1); PG8_BAR;
            PG8_LDA(At, 0, 1); PG8_STAGE(PG8_SA(0, 0), a2, voffA);
            PG8_BAR; PG8_WAIT_L(0); PG8_MMA(1, 0, At, B0); PG8_BAR; PG8_SCHED;
            PG8_STAGE(PG8_SB(0, 1), b2 + hstepB, voffB);
            PG8_WAIT_V(6); PG8_BAR; PG8_MMA(1, 1, At, B1); PG8_BAR;
            PG8_LDB(B0, 1, 0); PG8_SCHED; PG8_LDA(At, 1, 0); PG8_STAGE(PG8_SA(0, 1), a2 + hstepA, voffA);
            PG8_WAIT_L(8); PG8_BAR; PG8_WAIT_L(0); PG8_MMA(0, 0, At, B0); PG8_BAR; PG8_SCHED;
            PG8_LDB(B1, 1, 1); PG8_STAGE(PG8_SB(1, 0), b3, voffB);
            PG8_BAR; PG8_WAIT_L(0); PG8_MMA(0, 1, At, B1); PG8_BAR;
            PG8_LDA(At, 1, 1); PG8_STAGE(PG8_SA(1, 0), a3, voffA);
            PG8_BAR; PG8_WAIT_L(0); PG8_MMA(1, 0, At, B0); PG8_BAR; PG8_SCHED;
            PG8_STAGE(PG8_SB(1, 1), b3 + hstepB, voffB);
            PG8_WAIT_V(6); PG8_BAR; PG8_MMA(1, 1, At, B1); PG8_BAR;
            }
        }
        if constexpr (ALIGN_EPI) { if (wr == 0) PG8_BAR; }
        if constexpr (!Epi::AFTER_DRAIN) { int fr_ = fr, fq_ = fq; asm volatile("" : "+v"(fr_), "+v"(fq_));   E(acc, cur, wr, wc, fr_, fq_); S.done(cur); }
        if (!has_next) break;
#pragma unroll
        for (int a = 0; a < 2; ++a)
#pragma unroll
            for (int b = 0; b < 2; ++b)
#pragma unroll
                for (int m = 0; m < 4; ++m)
#pragma unroll
                    for (int n = 0; n < 2; ++n) acc[a][b][m][n] = (f32x4){0.f, 0.f, 0.f, 0.f};
        cur = nxt; cA = nA; cB = nB; ++ui;
        if constexpr (ALIGN_EPI) { if (wr == 1) PG8_BAR; }
    }
    PG8_WAIT_V(0);
    if constexpr (!ALIGN_EPI) { if (wr == 0) PG8_BAR; }
    PG8_BAR;
    if constexpr (Epi::AFTER_DRAIN) { E.fused(acc, cur, wr, wc, fr, fq, lds, wid, lane); S.done(cur); }
#undef PG8_SA
#undef PG8_SB
#undef PG8_STAGE
#undef PG8_LDA
#undef PG8_LDB
#undef PG8_MMA
#undef PG8_WAIT_V
#undef PG8_WAIT_L
#undef PG8_BAR
#undef PG8_SCHED
}
}
#define LAS __attribute__((address_space(3)))
typedef unsigned short bf16;
typedef unsigned v4u __attribute__((ext_vector_type(4)));
typedef unsigned v2u __attribute__((ext_vector_type(2)));
typedef float f32x4 __attribute__((ext_vector_type(4)));
typedef float f32x16 __attribute__((ext_vector_type(16)));
typedef short bf16x8 __attribute__((ext_vector_type(8)));
typedef short s16x4 __attribute__((ext_vector_type(4)));
constexpr int NB = 4, SEQ = 8192, DM = 1024, T = NB * SEQ, NIN = 5120, NH = 8;
constexpr size_t MiB = 1u << 20;
constexpr size_t WS_BAR = 0, BAR_ZERO_BYTES = 16384;
constexpr size_t WS_SSP = 1 * MiB;
constexpr size_t WS_W = 4 * MiB, W_LAYER = 14 * MiB;
constexpr size_t WS_XG = 32 * MiB;
constexpr size_t WS_VP = 96 * MiB, WS_ZP = 128 * MiB, WS_Q = 160 * MiB, WS_K = 192 * MiB, WS_V = 224 * MiB, WS_ZA = 256 * MiB;
constexpr size_t WS_G = 288 * MiB;
constexpr size_t WS_Y = 416 * MiB;
constexpr size_t WS_MG = WS_Q;
constexpr size_t WS_END = 480 * MiB;
constexpr int LDS_BYTES = 147456;
constexpr int LDS_MISC = 135168;
constexpr int NWAVES = 8, NTHREADS = 512;
constexpr int REP_P0 = 1, REP_P1 = 1, REP_P2 = 1, REP_P3A = 1, REP_SYNC = 1, REP_P3B = 1, REP_FIN = 1;

__device__ __forceinline__ unsigned f2bf(float f) { unsigned u = __builtin_bit_cast(unsigned, f); return (u + 0x7fffu + ((u >> 16) & 1u)) >> 16; }
__device__ __forceinline__ unsigned pk2(float lo, float hi) { return f2bf(lo) | (f2bf(hi) << 16); }
typedef float f32x2_t __attribute__((ext_vector_type(2))); typedef __bf16 bf16x2_t __attribute__((ext_vector_type(2)));
__device__ __forceinline__ unsigned cvtpk(float lo, float hi) { f32x2_t v = {lo, hi}; bf16x2_t b = __builtin_convertvector(v, bf16x2_t); return __builtin_bit_cast(unsigned, b); }
__device__ __forceinline__ float bflo(unsigned u) { return __uint_as_float(u << 16); }
__device__ __forceinline__ float bfhi(unsigned u) { return __uint_as_float(u & 0xffff0000u); }
__device__ __forceinline__ float wave_sum(float v) {
#pragma unroll
    for (int o = 1; o < 64; o <<= 1) v += __shfl_xor(v, o);
    return v;
}
#define LDS_WAIT() asm volatile("s_waitcnt lgkmcnt(0)" ::: "memory")

__device__ __forceinline__ void tr_item(const float* W, int ldw, bf16* WT, int ldt, int k0, int n0, int trow0, int tcol0, LAS float* scr, int lane) {
#pragma unroll 8
    for (int i = 0; i < 32; ++i) { const int kk = 2 * i + (lane >> 5); scr[kk * 33 + (lane & 31)] = W[(size_t)(k0 + kk) * ldw + n0 + (lane & 31)]; }
    LDS_WAIT();
    const int c = lane & 7;
#pragma unroll
    for (int j = 0; j < 4; ++j) { const int n = (lane >> 3) + 8 * j; const LAS float* s = scr + (8 * c) * 33 + n;
        v4u o; o.x = pk2(s[0 * 33], s[1 * 33]); o.y = pk2(s[2 * 33], s[3 * 33]); o.z = pk2(s[4 * 33], s[5 * 33]); o.w = pk2(s[6 * 33], s[7 * 33]);
        *(v4u*)(WT + (size_t)(trow0 + n) * ldt + tcol0 + 8 * c) = o; }
    LDS_WAIT();
}

#define RLX_AGENT __ATOMIC_RELAXED, __HIP_MEMORY_SCOPE_AGENT
#define XB_TMO      128
#define XB_XCNT(j)  (256  + 64 * (j))
#define XB_XSUB(j)  (1280 + 64 * (j))
#define XB_XGEN(j)  (2304 + 64 * (j))
#define XB_TOP      3328
#define XB_TOPGEN   3392
#define XCD_BAR_WORDS 3456
#define XB_SPIN_CAP (1u << 18)

__device__ __forceinline__ unsigned xb_ld(unsigned* p)              { return __hip_atomic_load(p, __ATOMIC_RELAXED, __HIP_MEMORY_SCOPE_AGENT); }
__device__ __forceinline__ unsigned xb_add(unsigned* p, unsigned v) { return __hip_atomic_fetch_add(p, v, __ATOMIC_RELAXED, __HIP_MEMORY_SCOPE_AGENT); }
__device__ __forceinline__ unsigned xb_xcc_id() { return (unsigned)__builtin_amdgcn_s_getreg((3 << 11) | 20) & 0xFu; }
#define XB_SPIN(cond, bar) do { unsigned _sp = 0; while (cond) { __builtin_amdgcn_s_sleep(1); \
    if ((++_sp & 255u) == 0u) { if (xb_ld(&(bar)[XB_TMO])) break; if (_sp > XB_SPIN_CAP) { atomicAdd(&(bar)[XB_TMO], 1u); break; } } } } while (0)

struct XcdBarrier {
    unsigned* bar; unsigned x;
    volatile LAS unsigned* st;
};

__device__ __forceinline__ XcdBarrier xcd_barrier_post(unsigned* bar, volatile LAS unsigned* st) {
    XcdBarrier b; b.bar = bar; b.x = xb_xcc_id(); b.st = st;
    if (threadIdx.x == 0) (void)xb_add(&bar[XB_XCNT(b.x)], 1u);
    return b;
}
__device__ __forceinline__ void xcd_barrier_complete(unsigned* bar, unsigned x, unsigned& nloc, unsigned& nx) {
    const unsigned G = gridDim.x * gridDim.y * gridDim.z;
    unsigned sum, cnt, mine, sp = 0u;
    for (;;) {
        sum = 0u; cnt = 0u; mine = 0u;
#pragma unroll
        for (unsigned j = 0; j < 16; ++j) { const unsigned c = xb_ld(&bar[XB_XCNT(j)]); sum += c; cnt += (c > 0u) ? 1u : 0u; mine = (j == x) ? c : mine; }
        if (sum == G) break;
        __builtin_amdgcn_s_sleep(1);
        if ((++sp & 255u) == 0u) { if (xb_ld(&bar[XB_TMO])) break; if (sp > XB_SPIN_CAP) { atomicAdd(&bar[XB_TMO], 1u); break; } }
    }
    nloc = mine > 0u ? mine : 1u; nx = cnt > 0u ? cnt : 1u;
}

__device__ __forceinline__ void xcd_barrier(const XcdBarrier& b) {
    asm volatile("s_waitcnt vmcnt(0)" ::: "memory");
    __syncthreads();
    if (threadIdx.x == 0) {
        unsigned* bar = b.bar;
        __builtin_amdgcn_s_waitcnt(0);
        unsigned nloc = b.st[0], nx = b.st[1];
        if (nloc == 0u) { xcd_barrier_complete(bar, b.x, nloc, nx); b.st[0] = nloc; b.st[1] = nx; }
        const unsigned old = xb_add(&bar[XB_XSUB(b.x)], 1u);
        const unsigned gen = old / nloc;
        if (old + 1u == (gen + 1u) * nloc) {
            __builtin_amdgcn_fence(__ATOMIC_RELEASE, "agent");
            asm volatile("s_waitcnt vmcnt(0)" ::: "memory");
            const unsigned og = xb_add(&bar[XB_TOP], 1u);
            const unsigned tg = og / nx;
            if (og + 1u == (tg + 1u) * nx) xb_add(&bar[XB_TOPGEN], 1u);
            else XB_SPIN(xb_ld(&bar[XB_TOPGEN]) == tg, bar);
            __builtin_amdgcn_fence(__ATOMIC_ACQUIRE, "agent");
            xb_add(&bar[XB_XGEN(b.x)], 1u);
            asm volatile("s_waitcnt vmcnt(0)" ::: "memory");
        } else {
            XB_SPIN(xb_ld(&bar[XB_XGEN(b.x)]) == gen, bar);
            __builtin_amdgcn_fence(__ATOMIC_ACQUIRE, "agent");
            asm volatile("s_waitcnt vmcnt(0)" ::: "memory");
        }
    }
    __syncthreads();
}
constexpr int VPITCH = 144;
constexpr float SB_EXIT = 160.0f;
__device__ __forceinline__ int crow(int r, int hi) { return (r & 3) + 8 * (r >> 2) + 4 * hi; }
__device__ __forceinline__ s16x4 vtr(const LAS unsigned char* p) { typedef short v4i16_t __attribute__((ext_vector_type(4)));
    return __builtin_bit_cast(s16x4, __builtin_amdgcn_ds_read_tr16_b64_v4i16((LAS v4i16_t*)p)); }
__device__ __forceinline__ void attn_unit(const bf16* __restrict__ Q, const bf16* __restrict__ K, const bf16* __restrict__ V, const bf16* __restrict__ ZA, bf16* __restrict__ Y,
                                          int b, int h, int qt, LAS unsigned char* vl, int lane) {
    const int j = lane & 31, hi = lane >> 5;
    const size_t row0 = (size_t)b * SEQ + (size_t)qt * 32;
    const bf16* qp = Q + (row0 + j) * 512 + h * 64 + 8 * hi;
    bf16x8 qf[4];
#pragma unroll
    for (int s = 0; s < 4; ++s) qf[s] = *(const bf16x8*)(qp + 16 * s);
    f32x16 o0, o1;
#pragma unroll
    for (int r = 0; r < 16; ++r) { o0[r] = 0.f; o1[r] = 0.f; }
    float carry = 0.f;
    const int blk = (lane >> 4) & 1, q4 = (lane & 15) >> 2, p4 = lane & 3;
    const unsigned trb = (unsigned)((4 * hi + q4) * VPITCH + (16 * blk + 4 * p4) * 2);
    const unsigned vwb = (unsigned)((lane >> 3) * VPITCH + (lane & 7) * 16);
    for (int kt = qt; kt >= 0; --kt) {
        const size_t krow0 = (size_t)b * SEQ + (size_t)kt * 32;
        const bf16* kp = K + (krow0 + j) * 512 + h * 64 + 8 * hi;
        bf16x8 kf[4];
#pragma unroll
        for (int s = 0; s < 4; ++s) kf[s] = *(const bf16x8*)(kp + 16 * s);
        const bf16* vp = V + (krow0 + (lane >> 3)) * 512 + h * 64 + (lane & 7) * 8;
        v4u vv[4];
#pragma unroll
        for (int i = 0; i < 4; ++i) vv[i] = *(const v4u*)(vp + (size_t)i * 8 * 512);
        f32x16 sc;
#pragma unroll
        for (int r = 0; r < 16; ++r) sc[r] = 0.f;
#pragma unroll
        for (int s = 0; s < 4; ++s) sc = __builtin_amdgcn_mfma_f32_32x32x16_bf16(kf[s], qf[s], sc, 0, 0, 0);
        asm volatile("" ::: "memory");
#pragma unroll
        for (int i = 0; i < 4; ++i) *(LAS v4u*)(vl + vwb + i * 8 * VPITCH) = vv[i];
        asm volatile("" ::: "memory");
        const bool diag = (kt == qt);
        float sp[16];
#pragma unroll
        for (int r = 0; r < 16; ++r) { const float z = sc[r]; const float e = __builtin_amdgcn_exp2f(-__builtin_fabsf(z));
            float x = __builtin_fmaxf(z, 0.f) + __builtin_amdgcn_logf(1.0f + e);
            if (diag && crow(r, hi) >= j) x = 0.f; sp[r] = x; }
        float R[4], Rp[4], Tt[4];
#pragma unroll
        for (int a = 0; a < 4; ++a) { R[a] = (sp[4 * a] + sp[4 * a + 1]) + (sp[4 * a + 2] + sp[4 * a + 3]); Rp[a] = __shfl_xor(R[a], 32); Tt[a] = R[a] + Rp[a]; }
        float suf = carry; float w[16];
#pragma unroll
        for (int a = 3; a >= 0; --a) { const float base = suf + (hi == 0 ? Rp[a] : 0.f);
            const float c3 = base + sp[4 * a + 3], c2 = c3 + sp[4 * a + 2], c1 = c2 + sp[4 * a + 1], c0 = c1 + sp[4 * a];
            w[4 * a + 3] = __builtin_amdgcn_exp2f(sc[4 * a + 3] - c3); w[4 * a + 2] = __builtin_amdgcn_exp2f(sc[4 * a + 2] - c2);
            w[4 * a + 1] = __builtin_amdgcn_exp2f(sc[4 * a + 1] - c1); w[4 * a] = __builtin_amdgcn_exp2f(sc[4 * a] - c0);
            suf += Tt[a]; }
        carry = suf;
        if (diag) {
#pragma unroll
            for (int r = 0; r < 16; ++r) if (crow(r, hi) >= j) w[r] = 0.f; }
        bf16x8 pf[2];
#pragma unroll
        for (int s = 0; s < 2; ++s) { v4u p; p.x = cvtpk(w[8 * s], w[8 * s + 1]); p.y = cvtpk(w[8 * s + 2], w[8 * s + 3]); p.z = cvtpk(w[8 * s + 4], w[8 * s + 5]); p.w = cvtpk(w[8 * s + 6], w[8 * s + 7]);
            pf[s] = __builtin_bit_cast(bf16x8, p); }
#pragma unroll
        for (int s = 0; s < 2; ++s) {
            { const s16x4 lo = vtr(vl + trb + (16 * s) * VPITCH), hh = vtr(vl + trb + (16 * s + 8) * VPITCH);
              const bf16x8 vf = (bf16x8){lo[0], lo[1], lo[2], lo[3], hh[0], hh[1], hh[2], hh[3]};
              o0 = __builtin_amdgcn_mfma_f32_32x32x16_bf16(vf, pf[s], o0, 0, 0, 0); }
            { const s16x4 lo = vtr(vl + trb + (16 * s) * VPITCH + 64), hh = vtr(vl + trb + (16 * s + 8) * VPITCH + 64);
              const bf16x8 vf = (bf16x8){lo[0], lo[1], lo[2], lo[3], hh[0], hh[1], hh[2], hh[3]};
              o1 = __builtin_amdgcn_mfma_f32_32x32x16_bf16(vf, pf[s], o1, 0, 0, 0); }
        }
        asm volatile("" ::: "memory");
        if (__ballot(carry < SB_EXIT) == 0ull) break;
    }
    const size_t zrow = (row0 + j) * 512 + h * 64, yrow = (row0 + j) * 1024 + 512 + h * 64;
#pragma unroll
    for (int a = 0; a < 4; ++a) { const int d0 = 8 * a + 4 * hi;
        { const v2u zz = *(const v2u*)(ZA + zrow + d0); v2u o; o.x = cvtpk(o0[4 * a] * bflo(zz.x), o0[4 * a + 1] * bfhi(zz.x)); o.y = cvtpk(o0[4 * a + 2] * bflo(zz.y), o0[4 * a + 3] * bfhi(zz.y));
          *(v2u*)(Y + yrow + d0) = o; }
        { const v2u zz = *(const v2u*)(ZA + zrow + 32 + d0); v2u o; o.x = cvtpk(o1[4 * a] * bflo(zz.x), o1[4 * a + 1] * bfhi(zz.x)); o.y = cvtpk(o1[4 * a + 2] * bflo(zz.y), o1[4 * a + 3] * bfhi(zz.y));
          *(v2u*)(Y + yrow + 32 + d0) = o; } }
}

__device__ __forceinline__ void unpack8(const v4u q, float (&f)[8]) { f[0] = bflo(q.x); f[1] = bfhi(q.x); f[2] = bflo(q.y); f[3] = bfhi(q.y); f[4] = bflo(q.z); f[5] = bfhi(q.z); f[6] = bflo(q.w); f[7] = bfhi(q.w); }
__device__ __forceinline__ void pool_task(const bf16* __restrict__ VP, const bf16* __restrict__ ZP, bf16* __restrict__ Y, int task) {
    const int chunk = task & 63, tb = task >> 6, g = chunk >> 4, w = 2 << g;
    const int t0 = tb * 64, pos0 = t0 & (SEQ - 1);
    const bf16* vp = VP + (size_t)t0 * 512 + chunk * 8; const bf16* zp = ZP + (size_t)t0 * 512 + chunk * 8; bf16* yp = Y + (size_t)t0 * 1024 + chunk * 8;
    float s[8];
#pragma unroll
    for (int e = 0; e < 8; ++e) s[e] = 0.f;
    for (int jj = 1; jj < w; ++jj) if (pos0 - jj >= 0) { float f[8]; unpack8(*(const v4u*)(vp - (ptrdiff_t)jj * 512), f);
#pragma unroll
        for (int e = 0; e < 8; ++e) s[e] += f[e]; }
#pragma unroll 4
    for (int t = 0; t < 64; ++t) { const int pos = pos0 + t;
        float v[8], z[8]; unpack8(*(const v4u*)(vp + (size_t)t * 512), v); unpack8(*(const v4u*)(zp + (size_t)t * 512), z);
        const float inv = 1.0f / (float)(pos + 1 < w ? pos + 1 : w);
        float y[8];
#pragma unroll
        for (int e = 0; e < 8; ++e) { s[e] += v[e]; y[e] = (s[e] * inv - v[e]) * z[e]; }
        v4u o; o.x = cvtpk(y[0], y[1]); o.y = cvtpk(y[2], y[3]); o.z = cvtpk(y[4], y[5]); o.w = cvtpk(y[6], y[7]);
        *(v4u*)(yp + (size_t)t * 1024) = o;
        if (pos + 1 >= w) { float f[8]; unpack8(*(const v4u*)(vp + (ptrdiff_t)(t + 1 - w) * 512), f);
#pragma unroll
            for (int e = 0; e < 8; ++e) s[e] -= f[e]; }
    }
}

struct Args { const float* in[10]; float* out; unsigned char* ws; };
__global__ void __launch_bounds__(NTHREADS, 2) fwd_megakernel(Args args) {
    extern __shared__ __attribute__((aligned(16))) unsigned char lds_raw[];
    LAS unsigned char* lds = (LAS unsigned char*)lds_raw;
    cg::grid_group grid = cg::this_grid();
    const int tid = threadIdx.x, lane = tid & 63, wave = __builtin_amdgcn_readfirstlane(tid >> 6);
    const int G = gridDim.x, bx = blockIdx.x, vcu = (G % 8 == 0) ? (bx % 8) * (G / 8) + bx / 8 : bx;
    const int gw = vcu * NWAVES + wave, NGW = G * NWAVES;
    volatile LAS unsigned* MISC = (volatile LAS unsigned*)(lds + LDS_MISC);
    if (tid < 4) MISC[tid] = 0u;
    __syncthreads();
    const XcdBarrier bar = xcd_barrier_post((unsigned*)(args.ws + WS_BAR), MISC);
    const float* x = args.in[0]; const float* norm_g = args.in[1]; const float* w_in = args.in[2]; const float* b_gate = args.in[3]; const float* pool_w = args.in[4];
    const float* pool_scale = args.in[5]; const float* w_pool_up = args.in[6]; const float* w_attn_up = args.in[7]; const float* w_out = args.in[8]; const float* final_g = args.in[9];
    float* out = args.out; unsigned char* ws = args.ws;
    float* SSP = (float*)(ws + WS_SSP);
    bf16* XG = (bf16*)(ws + WS_XG); bf16* VP = (bf16*)(ws + WS_VP); bf16* ZP = (bf16*)(ws + WS_ZP); bf16* Qb = (bf16*)(ws + WS_Q); bf16* Kb = (bf16*)(ws + WS_K);
    bf16* Vb = (bf16*)(ws + WS_V); bf16* ZA = (bf16*)(ws + WS_ZA); bf16* Gt = (bf16*)(ws + WS_G); bf16* Yb = (bf16*)(ws + WS_Y); bf16* MG = (bf16*)(ws + WS_MG);

#pragma nounroll
    for (int rep = 0; rep < REP_P0; ++rep) {
        LAS float* PW = (LAS float*)lds; LAS float* WI = (LAS float*)(lds + 65536);
        for (int it = vcu; it < 256; it += G) {
            const int l = it >> 7, g = (it >> 5) & 3, k0 = (it & 31) * 32;
            const float* pw = pool_w + ((size_t)l * 4 + g) * 16384; const float* wi = w_in + (size_t)l * DM * NIN + (size_t)k0 * NIN + g * 128;
            __syncthreads();
#pragma unroll 4
            for (int i = 0; i < 32; ++i) PW[tid + 512 * i] = pw[tid + 512 * i];
#pragma unroll
            for (int i = 0; i < 8; ++i) { const int idx = tid + 512 * i; WI[idx] = wi[(size_t)(idx >> 7) * NIN + (idx & 127)]; }
            __syncthreads();
            const int d = tid & 127, kq = tid >> 7; float acc[8];
#pragma unroll
            for (int e = 0; e < 8; ++e) acc[e] = 0.f;
            for (int c = 0; c < 128; ++c) { const float p = PW[c * 128 + d];
#pragma unroll
                for (int e = 0; e < 8; ++e) acc[e] += WI[(kq * 8 + e) * 128 + c] * p; }
            const float sc = pool_scale[l * 512 + g * 128 + d];
            v4u o; o.x = pk2(acc[0] * sc, acc[1] * sc); o.y = pk2(acc[2] * sc, acc[3] * sc); o.z = pk2(acc[4] * sc, acc[5] * sc); o.w = pk2(acc[6] * sc, acc[7] * sc);
            bf16* wt = (bf16*)(ws + WS_W + (size_t)l * W_LAYER);
            *(v4u*)(wt + (size_t)(g * 128 + d) * 1024 + k0 + kq * 8) = o;
        }
        __syncthreads();
        LAS float* scr = (LAS float*)(lds + wave * 16384);
        for (int it = gw; it < 6656; it += NGW) {
            const int l = it / 3328; int r = it % 3328;
            bf16* win_t = (bf16*)(ws + WS_W + (size_t)l * W_LAYER); bf16* wpa_t = win_t + (size_t)NIN * 1024; bf16* wout_t = wpa_t + (size_t)1024 * 1024;
            if (r < 2304) { const int kb = r / 144, nb = r % 144; tr_item(w_in + (size_t)l * DM * NIN, NIN, win_t, 1024, kb * 64, 512 + nb * 32, 512 + nb * 32, kb * 64, scr, lane); continue; } r -= 2304;
            if (r < 256) { const int kb = r / 32, nb = r % 32; tr_item(w_pool_up + (size_t)l * 512 * 1024, 1024, wpa_t, 1024, kb * 64, nb * 32, nb * 32, kb * 64, scr, lane); continue; } r -= 256;
            if (r < 256) { const int kb = r / 32, nb = r % 32; tr_item(w_attn_up + (size_t)l * 512 * 1024, 1024, wpa_t, 1024, kb * 64, nb * 32, nb * 32, 512 + kb * 64, scr, lane); continue; } r -= 256;
            { const int kb = r / 32, nb = r % 32; tr_item(w_out + (size_t)l * 1024 * 1024, 1024, wout_t, 1024, kb * 64, nb * 32, nb * 32, kb * 64, scr, lane); }
        }
        for (int m = gw; m < T; m += NGW) {
            const f32x4* xr = (const f32x4*)(x + (size_t)m * DM) + lane; const f32x4* gr = (const f32x4*)norm_g + lane;
            f32x4 v[4]; float s = 0.f;
#pragma unroll
            for (int jx = 0; jx < 4; ++jx) { v[jx] = xr[64 * jx]; s += (v[jx][0] * v[jx][0] + v[jx][1] * v[jx][1]) + (v[jx][2] * v[jx][2] + v[jx][3] * v[jx][3]); }
            s = wave_sum(s);
            v2u* o8 = (v2u*)(XG + (size_t)m * DM) + lane;
#pragma unroll
            for (int jx = 0; jx < 4; ++jx) { const f32x4 gg = gr[64 * jx]; v2u o; o.x = pk2(v[jx][0] * gg[0], v[jx][1] * gg[1]); o.y = pk2(v[jx][2] * gg[2], v[jx][3] * gg[3]); o8[64 * jx] = o; }
            if (lane < 16) SSP[(size_t)m * 16 + lane] = (lane == 0) ? s : 0.f;
        }
    }
    grid.sync();

    for (int l = 0; l < 2; ++l) {
        const bf16* win_t = (const bf16*)(ws + WS_W + (size_t)l * W_LAYER); const bf16* wpa_t = win_t + (size_t)NIN * 1024; const bf16* wout_t = wpa_t + (size_t)1024 * 1024;
#pragma nounroll
        for (int rep = 0; rep < REP_P1; ++rep) {   pg8::Gemm g{XG, win_t, T, NIN, DM, DM, DM}; pg8::StaticOrder S; S.init(T, NIN, G, bx);
            pg8::EpiProj E{VP, ZP, Qb, Kb, Vb, ZA, Gt, SSP, b_gate + l * 2048};
            pg8::gemm_phase<pg8::EpiProj, pg8::StaticOrder, true, true>(lds, g, S, E); }
#pragma nounroll
        for (int rep = 0; rep < REP_SYNC; ++rep) xcd_barrier(bar);
#pragma nounroll
        for (int rep = 0; rep < REP_P2; ++rep) {   LAS unsigned char* vl = lds + wave * 8192;
            for (int u = gw; u < NB * NH * (SEQ / 32); u += NGW) { const int qt = u & 255, bh = u >> 8; attn_unit(Qb, Kb, Vb, ZA, Yb, bh >> 3, bh & 7, qt, vl, lane); }
            for (int task = vcu * NTHREADS + tid; task < (T / 64) * 64; task += G * NTHREADS) pool_task(VP, ZP, Yb, task); }
        xcd_barrier(bar);
#pragma nounroll
        for (int rep = 0; rep < REP_P3A; ++rep) {   pg8::StaticOrder S; S.init(T, DM, G, bx);
            { pg8::Gemm g{Yb, wpa_t, T, DM, 512, 1024, 1024}; pg8::EpiMerge<0> E{MG, Gt}; pg8::gemm_phase<pg8::EpiMerge<0>, pg8::StaticOrder, true, true>(lds, g, S, E); }
            { pg8::Gemm g{Yb + 512, wpa_t + 512, T, DM, 512, 1024, 1024}; pg8::EpiMerge<1> E{MG, Gt}; pg8::gemm_phase<pg8::EpiMerge<1>, pg8::StaticOrder, true, true>(lds, g, S, E); } }
        xcd_barrier(bar);
#pragma nounroll
        for (int rep = 0; rep < (l == 0 ? REP_P3B : 1); ++rep) {   pg8::Gemm g{MG, wout_t, T, DM, DM, DM, DM}; pg8::StaticOrder S; S.init(T, DM, G, bx);
            pg8::EpiOut E{l == 0 ? x : (const float*)out, out, XG, norm_g + 1024, SSP, l == 0 ? 1 : 0};
            pg8::gemm_phase<pg8::EpiOut, pg8::StaticOrder, true, true>(lds, g, S, E); }
        xcd_barrier(bar);
    }
#pragma nounroll
    for (int rep = 0; rep < REP_FIN; ++rep)
    for (int m = gw; m < T; m += NGW) {
        float ss = SSP[(size_t)m * 16 + (lane & 15)];
        ss += __shfl_xor(ss, 1); ss += __shfl_xor(ss, 2); ss += __shfl_xor(ss, 4); ss += __shfl_xor(ss, 8);
        const float rstd = __builtin_amdgcn_rsqf(ss * (1.0f / 1024.0f) + 1e-6f);
        f32x4* xr = (f32x4*)(out + (size_t)m * DM) + lane; const f32x4* gr = (const f32x4*)final_g + lane;
        f32x4* xw = (rep == REP_FIN - 1) ? xr : (f32x4*)((float*)(ws + WS_G) + (size_t)m * DM) + lane;
#pragma unroll
        for (int jx = 0; jx < 4; ++jx) { const f32x4 v = xr[64 * jx]; xw[64 * jx] = v * rstd * gr[64 * jx]; }
    }
}

extern "C" void kernel_launch(void* const* d_in, const int* in_sizes, int n_in, void* d_out, int out_size, void* d_ws, size_t ws_size, hipStream_t stream) {
    static int grid = 0;
    if (grid == 0) {
        if (n_in != 10 || in_sizes[0] != T * DM || out_size != T * DM || ws_size < WS_END) { fprintf(stderr, "kernel_launch: unexpected shapes / workspace (ws %zu, need %zu)\n", ws_size, (size_t)WS_END); grid = -1; return; }
        int dev = 0, cus = 0, per_cu = 0;
        hipGetDevice(&dev); hipDeviceGetAttribute(&cus, hipDeviceAttributeMultiprocessorCount, dev);
        hipFuncSetAttribute((const void*)fwd_megakernel, hipFuncAttributeMaxDynamicSharedMemorySize, LDS_BYTES);
        hipOccupancyMaxActiveBlocksPerMultiprocessor(&per_cu, (const void*)fwd_megakernel, NTHREADS, LDS_BYTES);
        if (per_cu < 1) { fprintf(stderr, "kernel_launch: occupancy query says %d blocks per CU\n", per_cu); per_cu = 1; }
        grid = cus * per_cu;
    }
    if (grid < 0) return;
    if (hipMemsetAsync((char*)d_ws + WS_BAR, 0, BAR_ZERO_BYTES, stream) != hipSuccess) { fprintf(stderr, "kernel_launch: memset of the barrier words failed\n"); return; }
    Args a{};
    for (int i = 0; i < 10; ++i) a.in[i] = (const float*)d_in[i];
    a.out = (float*)d_out; a.ws = (unsigned char*)d_ws;
    void* kargs[] = {&a};
    hipError_t e = hipLaunchCooperativeKernel((const void*)fwd_megakernel, dim3(grid), dim3(NTHREADS), kargs, LDS_BYTES, stream);
    if (e != hipSuccess) fprintf(stderr, "cooperative launch failed: %s (grid %d)\n", hipGetErrorString(e), grid);
}
```

```cpp
#include <hip/hip_runtime.h>
#include <hip/hip_cooperative_groups.h>
#include <cstdio>
#include <cstdint>
namespace cg = cooperative_groups;
namespace pg8 {
#define PG8_LAS __attribute__((address_space(3)))
typedef unsigned short bf16_t;
typedef short bf16x8 __attribute__((ext_vector_type(8)));
typedef float f32x4 __attribute__((ext_vector_type(4)));
typedef unsigned u32x4 __attribute__((ext_vector_type(4)));
constexpr int BM = 256, BK = 64, HALF = 128, HTB = HALF * BK * 2  , STAGE_BYTES = 8 * HTB, NXCD = 8, WGM = 8;

__host__ __device__ __forceinline__ int lds_byte(int r, int c) { const int st = (r >> 4) * 2 + (c >> 5), rr = r & 15, cc = c & 31, ob = rr * 64 + cc * 2; return st * 1024 + (ob ^ (((ob >> 9) & 1) << 5)); }
__host__ __device__ __forceinline__ void stage_rc(int b, int& R, int& C) { const int st = b / 1024, sb = b % 1024, swz = sb ^ (((sb >> 9) & 1) << 5); R = (st >> 1) * 16 + swz / 64; C = (st & 1) * 32 + (swz % 64) / 2; }
__host__ __device__ __forceinline__ int perm32(int rho) { const int n = rho >> 4, i = rho & 15; return 8 * (i >> 2) + 4 * n + (i & 3); }

struct Unit { int pm, pn; };
struct Gemm { const bf16_t* A; const bf16_t* Bt; int M, N, K, lda, ldb; };

struct StaticOrder {
    int nM, nN, nwg, G, c;
    __host__ __device__ void init(int M, int N, int G_, int c_) { nM = M / BM; nN = N / BM; nwg = nM * nN; G = G_; c = c_; }
    __host__ __device__ bool next(int i, Unit& u) const {
        const long L = (long)i * G + c; if (L >= nwg) return false;
        int wgid = (int)L; { const int q = nwg / NXCD, r = nwg % NXCD, xcd = wgid % NXCD, off = wgid / NXCD; wgid = (xcd < r ? xcd * (q + 1) : r * (q + 1) + (xcd - r) * q) + off; }
        const int nig = WGM * nN, gid = wgid / nig, fm = gid * WGM, gsz = (nM - fm) < WGM ? (nM - fm) : WGM;
        u.pm = fm + ((wgid % nig) % gsz); u.pn = (wgid % nig) / gsz; return true;
    }
    __device__ __forceinline__ void a_ready(const Unit&) const {}
    __device__ __forceinline__ void done(const Unit&) const {}
};

__device__ __forceinline__ unsigned cvt_pk_bf16(float lo, float hi) { unsigned r; asm volatile("v_cvt_pk_bf16_f32 %0, %1, %2" : "=v"(r) : "v"(lo), "v"(hi)); return r; }
typedef float f32x2 __attribute__((ext_vector_type(2)));
__device__ __forceinline__ float bf_lo(unsigned u) { return __uint_as_float(u << 16); }
__device__ __forceinline__ float bf_hi(unsigned u) { return __uint_as_float(u & 0xffff0000u); }
__device__ __forceinline__ float sigmoid_f(float v) { return __builtin_amdgcn_rcpf(1.0f + __builtin_amdgcn_exp2f(-1.4426950408889634f * v)); }
constexpr float RMS_EPS_F = 1e-6f;
constexpr float QSCALE = 0.125f * 1.4426950408889634f;

struct EpiProj {
    static constexpr bool PERM = true, AFTER_DRAIN = false;
    bf16_t *VP, *ZP, *Q, *K, *V, *ZA, *G; const float* ssp; const float* bgate;
    __device__ __forceinline__ void operator()(const f32x4 (&acc)[2][2][4][2], const Unit& u, int wr, int wc, int fr, int fq) const {
        const int pn = u.pn; bf16_t* base; int ld, mode, colt; float sc = 1.f;
        if (pn < 12) { const int seg = pn >> 1; colt = (pn & 1) * 256; ld = 512;
            base = seg == 0 ? VP : seg == 1 ? ZP : seg == 2 ? Q : seg == 3 ? K : seg == 4 ? V : ZA;
            mode = (seg == 1 || seg == 5) ? 1 : 0; if (seg == 2) sc = QSCALE; }
        else { base = G; colt = (pn - 12) * 256; ld = 2048; mode = 2; }
        const int row0 = u.pm * BM + wr * 64 + fr, col0 = colt + wc * 32 + 8 * fq;
        f32x4 bv[2][2];
#pragma unroll
        for (int bj = 0; bj < 2; ++bj)
#pragma unroll
            for (int n = 0; n < 2; ++n) bv[bj][n] = (mode == 2) ? *(const f32x4*)(bgate + col0 + bj * HALF + 4 * n) : (f32x4){0.f, 0.f, 0.f, 0.f};
#pragma unroll
        for (int ai = 0; ai < 2; ++ai)
#pragma unroll
            for (int m = 0; m < 4; ++m) { const int row = row0 + ai * HALF + m * 16;
                const f32x4 st = *((const f32x4*)(ssp + (size_t)row * 16) + fq);
                float ss = (st[0] + st[1]) + (st[2] + st[3]); ss += __shfl_xor(ss, 16); ss += __shfl_xor(ss, 32);
                const float rstd = __builtin_amdgcn_rsqf(ss * (1.0f / 1024.0f) + RMS_EPS_F) * sc;
                bf16_t* rowp = base + (size_t)row * ld + col0;
#pragma unroll
                for (int bj = 0; bj < 2; ++bj) { f32x4 v0 = acc[ai][bj][m][0] * rstd, v1 = acc[ai][bj][m][1] * rstd;
                    if (mode == 2) { v0 = v0 + bv[bj][0]; v1 = v1 + bv[bj][1];
#pragma unroll
                        for (int e = 0; e < 4; ++e) { v0[e] = sigmoid_f(v0[e]); v1[e] = sigmoid_f(v1[e]); } }
                    else if (mode == 1) {
#pragma unroll
                        for (int e = 0; e < 4; ++e) { v0[e] = v0[e] * sigmoid_f(v0[e]); v1[e] = v1[e] * sigmoid_f(v1[e]); } }
                    u32x4 w; w.x = cvt_pk_bf16(v0[0], v0[1]); w.y = cvt_pk_bf16(v0[2], v0[3]); w.z = cvt_pk_bf16(v1[0], v1[1]); w.w = cvt_pk_bf16(v1[2], v1[3]);
                    *(u32x4*)(rowp + bj * HALF) = w; } }
    }
};
template <int PASS> struct EpiMerge {
    static constexpr bool PERM = true, AFTER_DRAIN = false;
    bf16_t* MG; const bf16_t* G;
    __device__ __forceinline__ void operator()(const f32x4 (&acc)[2][2][4][2], const Unit& u, int wr, int wc, int fr, int fq) const {
        const int row0 = u.pm * BM + wr * 64 + fr, col0 = u.pn * BM + wc * 32 + 8 * fq;
#pragma unroll
        for (int ai = 0; ai < 2; ++ai)
#pragma unroll
            for (int m = 0; m < 4; ++m) { const int row = row0 + ai * HALF + m * 16;
#pragma unroll
                for (int bj = 0; bj < 2; ++bj) { const int col = col0 + bj * HALF;
                    const u32x4 gq = *(const u32x4*)(G + (size_t)row * 2048 + PASS * 1024 + col);
                    f32x4 v0 = acc[ai][bj][m][0], v1 = acc[ai][bj][m][1];
                    v0[0] *= bf_lo(gq.x); v0[1] *= bf_hi(gq.x); v0[2] *= bf_lo(gq.y); v0[3] *= bf_hi(gq.y);
                    v1[0] *= bf_lo(gq.z); v1[1] *= bf_hi(gq.z); v1[2] *= bf_lo(gq.w); v1[3] *= bf_hi(gq.w);
                    u32x4* mp = (u32x4*)(MG + (size_t)row * 1024 + col);
                    if (PASS == 1) { const u32x4 pq = *mp;
                        v0[0] += bf_lo(pq.x); v0[1] += bf_hi(pq.x); v0[2] += bf_lo(pq.y); v0[3] += bf_hi(pq.y);
                        v1[0] += bf_lo(pq.z); v1[1] += bf_hi(pq.z); v1[2] += bf_lo(pq.w); v1[3] += bf_hi(pq.w); }
                    u32x4 w; w.x = cvt_pk_bf16(v0[0], v0[1]); w.y = cvt_pk_bf16(v0[2], v0[3]); w.z = cvt_pk_bf16(v1[0], v1[1]); w.w = cvt_pk_bf16(v1[2], v1[3]);
                    *mp = w; } }
    }
};
struct EpiOut {
    static constexpr bool PERM = false, AFTER_DRAIN = false;
    const float* xin; float* xout; bf16_t* XG; const float* gnext; float* ssp; int write_xg;
    __device__ __forceinline__ void operator()(const f32x4 (&acc)[2][2][4][2], const Unit& u, int wr, int wc, int fr, int fq) const {
        typedef unsigned u32x2v __attribute__((ext_vector_type(2)));
        const int col0 = u.pn * BM + wc * 32 + 4 * fq;
#pragma unroll
        for (int ai = 0; ai < 2; ++ai)
#pragma unroll
            for (int m = 0; m < 4; ++m) { const int row = u.pm * BM + ai * HALF + wr * 64 + m * 16 + fr; const size_t off = (size_t)row * 1024 + col0; float ss = 0.f;
#pragma unroll
                for (int bj = 0; bj < 2; ++bj)
#pragma unroll
                    for (int n = 0; n < 2; ++n) { const int co = bj * HALF + n * 16;
                        const f32x4 v = *(const f32x4*)(xin + off + co) + acc[ai][bj][m][n];
                        *(f32x4*)(xout + off + co) = v; ss += (v[0] * v[0] + v[1] * v[1]) + (v[2] * v[2] + v[3] * v[3]);
                        if (write_xg) { const f32x4 gg = *(const f32x4*)(gnext + col0 + co); u32x2v w; w.x = cvt_pk_bf16(v[0] * gg[0], v[1] * gg[1]); w.y = cvt_pk_bf16(v[2] * gg[2], v[3] * gg[3]);
                            *(u32x2v*)(XG + off + co) = w; } }
                ss += __shfl_xor(ss, 16); ss += __shfl_xor(ss, 32);
                if (fq == 0) ssp[(size_t)row * 16 + u.pn * 4 + wc] = ss; }
    }
};
template <class Epi, class Sched, bool ALIGN_EPI = false, bool SP2 = false>
__device__ __forceinline__ void gemm_phase(PG8_LAS unsigned char* lds, const Gemm g_in, const Sched& S, const Epi& E) {
    Gemm g = g_in; asm volatile("" : "+s"(g.A), "+s"(g.Bt));
    int tid_ = threadIdx.x; asm volatile("" : "+v"(tid_));
    const int tid = tid_, wid = __builtin_amdgcn_readfirstlane(tid >> 6), lane = tid & 63, wr = wid >> 2, wc = wid & 3, fr = lane & 15, fq = lane >> 4;
    const int K = g.K, nt = K / BK;
    unsigned voffA[2], voffB[2];
#pragma unroll
    for (int i = 0; i < 2; ++i) { int R, C; stage_rc(tid * 16 + i * 8192, R, C); const int Rb = Epi::PERM ? ((R & ~31) + perm32(R & 31)) : R;
        voffA[i] = (unsigned)(R * g.lda + C) * 2u; voffB[i] = (unsigned)(Rb * g.ldb + C) * 2u; }
    const size_t kstep = (size_t)(BK * 2);
    const size_t hstepA = (size_t)HALF * g.lda * 2, hstepB = (size_t)HALF * g.ldb * 2;
    const size_t tstepA = 2 * hstepA, tstepB = 2 * hstepB;
    const unsigned ldsw = (unsigned)wid * 1024u;
    const int aoff = lds_byte(wr * 64 + fr, fq * 8), boff = lds_byte(wc * 32 + fr, fq * 8);
#define PG8_SA(b, h) (((b) * 2 + (h)) * HTB)
#define PG8_SB(b, h) ((4 + (b) * 2 + (h)) * HTB)
#define PG8_STAGE(bufoff, gbase, voff) do { _Pragma("unroll") for (int _i = 0; _i < 2; ++_i) \
        __builtin_amdgcn_global_load_lds((const unsigned*)((const char*)(gbase) + (voff)[_i]), (PG8_LAS unsigned*)(lds + (bufoff) + ldsw + _i * 8192), 16, 0, 0); } while (0)
#define PG8_LDA(dst, b, h) do { _Pragma("unroll") for (int m = 0; m < 4; ++m) _Pragma("unroll") for (int k = 0; k < 2; ++k) dst[m][k] = *(const PG8_LAS bf16x8*)(lds + PG8_SA(b, h) + aoff + m * 2048 + k * 1024); } while (0)
#define PG8_LDB(dst, b, h) do { _Pragma("unroll") for (int n = 0; n < 2; ++n) _Pragma("unroll") for (int k = 0; k < 2; ++k) dst[n][k] = *(const PG8_LAS bf16x8*)(lds + PG8_SB(b, h) + boff + n * 2048 + k * 1024); } while (0)
#define PG8_MMA(ai, bj, At, Bt) do { __builtin_amdgcn_s_setprio(1); _Pragma("unroll") for (int m = 0; m < 4; ++m) _Pragma("unroll") for (int n = 0; n < 2; ++n) _Pragma("unroll") for (int k = 0; k < 2; ++k) \
        acc[ai][bj][m][n] = __builtin_amdgcn_mfma_f32_16x16x32_bf16(Bt[n][k], At[m][k], acc[ai][bj][m][n], 0, 0, 0); __builtin_amdgcn_s_setprio(0); } while (0)
#define PG8_WAIT_V(n) asm volatile("s_waitcnt vmcnt(" #n ")" ::: "memory")
#define PG8_WAIT_L(n) asm volatile("s_waitcnt lgkmcnt(" #n ")" ::: "memory")
#define PG8_BAR __builtin_amdgcn_s_barrier()
#define PG8_SCHED __builtin_amdgcn_sched_barrier(0)
    Unit cur, nxt; int ui = 0;
    if (!S.next(0, cur)) return;
    f32x4 acc[2][2][4][2];
#pragma unroll
    for (int a = 0; a < 2; ++a)
#pragma unroll
        for (int b = 0; b < 2; ++b)
#pragma unroll
            for (int m = 0; m < 4; ++m)
#pragma unroll
                for (int n = 0; n < 2; ++n) acc[a][b][m][n] = (f32x4){0.f, 0.f, 0.f, 0.f};
    bf16x8 At[4][2], B0[2][2], B1[2][2];
    const char* cA = (const char*)g.A + (size_t)cur.pm * tstepA; const char* cB = (const char*)g.Bt + (size_t)cur.pn * tstepB;
    S.a_ready(cur);
    if constexpr (SP2) {
        PG8_STAGE(PG8_SB(0, 0), cB, voffB); PG8_STAGE(PG8_SB(0, 1), cB + hstepB, voffB); PG8_STAGE(PG8_SA(0, 0), cA, voffA); PG8_STAGE(PG8_SA(0, 1), cA + hstepA, voffA);
        if (wr == 1) PG8_BAR;
        PG8_WAIT_V(2); PG8_BAR;
        PG8_STAGE(PG8_SB(1, 0), cB + kstep, voffB); PG8_STAGE(PG8_SA(1, 0), cA + kstep, voffA); PG8_STAGE(PG8_SB(1, 1), cB + hstepB + kstep, voffB);
        PG8_WAIT_V(6); PG8_BAR;
    } else {
        PG8_STAGE(PG8_SB(0, 0), cB, voffB); PG8_STAGE(PG8_SA(0, 0), cA, voffA); PG8_STAGE(PG8_SB(0, 1), cB + hstepB, voffB); PG8_STAGE(PG8_SA(0, 1), cA + hstepA, voffA);
        if (wr == 1) PG8_BAR;
        PG8_WAIT_V(4); PG8_BAR;
        PG8_STAGE(PG8_SB(1, 0), cB + kstep, voffB); PG8_STAGE(PG8_SA(1, 0), cA + kstep, voffA); PG8_STAGE(PG8_SB(1, 1), cB + hstepB + kstep, voffB);
        PG8_WAIT_V(6); PG8_BAR;
    }
    for (;;) {
        const bool has_next = S.next(ui + 1, nxt);
        const char* nA = has_next ? (const char*)g.A + (size_t)nxt.pm * tstepA : cA; const char* nB = has_next ? (const char*)g.Bt + (size_t)nxt.pn * tstepB : cB;
        for (int t = 0; t < nt; t += 2) {
            const bool last = (t == nt - 2);
            const char* a1 = cA + (size_t)(t + 1) * kstep;
            const char* a2 = last ? nA : cA + (size_t)(t + 2) * kstep; const char* b2 = last ? nB : cB + (size_t)(t + 2) * kstep;
            const char* a3 = a2 + kstep; const char* b3 = b2 + kstep;
            if (last && has_next) S.a_ready(nxt);
            if constexpr (SP2) {
            PG8_LDB(B0, 0, 0); PG8_LDB(B1, 0, 1); PG8_SCHED; PG8_LDA(At, 0, 0); PG8_STAGE(PG8_SA(1, 1), a1 + hstepA, voffA);
            PG8_WAIT_V(8); PG8_WAIT_L(0); PG8_BAR; PG8_MMA(0, 0, At, B0); PG8_MMA(0, 1, At, B1); PG8_BAR; PG8_SCHED;
            PG8_LDA(At, 0, 1); PG8_STAGE(PG8_SB(0, 0), b2, voffB); PG8_STAGE(PG8_SB(0, 1), b2 + hstepB, voffB); PG8_STAGE(PG8_SA(0, 0), a2, voffA);
            PG8_WAIT_V(8); PG8_WAIT_L(0); PG8_BAR; PG8_MMA(1, 0, At, B0); PG8_MMA(1, 1, At, B1); PG8_BAR; PG8_SCHED;
            PG8_LDB(B0, 1, 0); PG8_LDB(B1, 1, 1); PG8_SCHED; PG8_LDA(At, 1, 0); PG8_STAGE(PG8_SA(0, 1), a2 + hstepA, voffA);
            PG8_WAIT_V(8); PG8_WAIT_L(0); PG8_BAR; PG8_MMA(0, 0, At, B0); PG8_MMA(0, 1, At, B1); PG8_BAR; PG8_SCHED;
            PG8_LDA(At, 1, 1); PG8_STAGE(PG8_SB(1, 0), b3, voffB); PG8_STAGE(PG8_SB(1, 1), b3 + hstepB, voffB); PG8_STAGE(PG8_SA(1, 0), a3, voffA);
            PG8_WAIT_V(8); PG8_WAIT_L(0); PG8_BAR; PG8_MMA(1, 0, At, B0); PG8_MMA(1, 1, At, B1); PG8_BAR; PG8_SCHED;
            } else {
            PG8_LDB(B0, 0, 0); PG8_SCHED; PG8_LDA(At, 0, 0); PG8_STAGE(PG8_SA(1, 1), a1 + hstepA, voffA);
            PG8_WAIT_L(8); PG8_BAR; PG8_WAIT_L(0); PG8_MMA(0, 0, At, B0); PG8_BAR; PG8_SCHED;
            PG8_LDB(B1, 0, 1); PG8_STAGE(PG8_SB(0, 0), b2, voffB);
            PG8_BAR; PG8_WAIT_L(0); PG8_MMA(0, 1, At, B1); PG8_BAR;
            PG8_LDA(At, 0, 1); PG8_STAGE(PG8_SA(0, 0), a2, voffA);
            PG8_BAR; PG8_WAIT_L(0); PG8_MMA(1, 0, At, B0); PG8_BAR; PG8_SCHED;
            PG8_STAGE(PG8_SB(0, 1), b2 + hstepB, voffB);
            PG8_WAIT_V(6); PG8_BAR; PG8_MMA(1, 1, At, B1); PG8_BAR;
            PG8_LDB(B0, 1, 0); PG8_SCHED; PG8_LDA(At, 1, 0); PG8_STAGE(PG8_SA(0, 1), a2 + hstepA, voffA);
            PG8_WAIT_L(8); PG8_BAR; PG8_WAIT_L(0); PG8_MMA(0, 0, At, B0); PG8_BAR; PG8_SCHED;
            PG8_LDB(B1, 1, 1); PG8_STAGE(PG8_SB(1, 0), b3, voffB);
            PG8_BAR; PG8_WAIT_L(0); PG8_MMA(0, 1, At, B1); PG8_BAR;
            PG8_LDA(At, 1, 1); PG8_STAGE(PG8_SA(1, 0), a3, voffA);
            PG8_BAR; PG8_WAIT_L(0); PG8_MMA(1, 0, At, B0); PG8_BAR; PG8_SCHED;
            PG8_STAGE(PG8_SB(1, 1), b3 + hstepB, voffB);
            PG8_WAIT_V(6); PG8_BAR; PG8_MMA(1, 1, At, B1); PG8_BAR;
            }
        }
        if constexpr (ALIGN_EPI) { if (wr == 0) PG8_BAR; }
        if constexpr (!Epi::AFTER_DRAIN) { int fr_ = fr, fq_ = fq; asm volatile("" : "+v"(fr_), "+v"(fq_));   E(acc, cur, wr, wc, fr_, fq_); S.done(cur); }
        if (!has_next) break;
#pragma unroll
        for (int a = 0; a < 2; ++a)
#pragma unroll
            for (int b = 0; b < 2; ++b)
#pragma unroll
                for (int m = 0; m < 4; ++m)
#pragma unroll
                    for (int n = 0; n < 2; ++n) acc[a][b][m][n] = (f32x4){0.f, 0.f, 0.f, 0.f};
        cur = nxt; cA = nA; cB = nB; ++ui;
        if constexpr (ALIGN_EPI) { if (wr == 1) PG8_BAR; }
    }
    PG8_WAIT_V(0);
    if constexpr (!ALIGN_EPI) { if (wr == 0) PG8_BAR; }
    PG8_BAR;
    if constexpr (Epi::AFTER_DRAIN) { E.fused(acc, cur, wr, wc, fr, fq, lds, wid, lane); S.done(cur); }
#undef PG8_SA
#undef PG8_SB
#undef PG8_STAGE
#undef PG8_LDA
#undef PG8_LDB
#undef PG8_MMA
#undef PG8_WAIT_V
#undef PG8_WAIT_L
#undef PG8_BAR
#undef PG8_SCHED
}
}
#define LAS __attribute__((address_space(3)))
typedef unsigned short bf16;
typedef unsigned v4u __attribute__((ext_vector_type(4)));
typedef unsigned v2u __attribute__((ext_vector_type(2)));
typedef float f32x4 __attribute__((ext_vector_type(4)));
typedef float f32x16 __attribute__((ext_vector_type(16)));
typedef short bf16x8 __attribute__((ext_vector_type(8)));
typedef short s16x4 __attribute__((ext_vector_type(4)));
constexpr int NB = 4, SEQ = 8192, DM = 1024, T = NB * SEQ, NIN = 5120, NH = 8;
constexpr size_t MiB = 1u << 20;
constexpr size_t WS_BAR = 0, BAR_ZERO_BYTES = 16384;
constexpr size_t WS_SSP = 1 * MiB;
constexpr size_t WS_W = 4 * MiB, W_LAYER = 14 * MiB;
constexpr size_t WS_XG = 32 * MiB;
constexpr size_t WS_VP = 96 * MiB, WS_ZP = 128 * MiB, WS_Q = 160 * MiB, WS_K = 192 * MiB, WS_V = 224 * MiB, WS_ZA = 256 * MiB;
constexpr size_t WS_G = 288 * MiB;
constexpr size_t WS_Y = 416 * MiB;
constexpr size_t WS_MG = WS_Q;
constexpr size_t WS_END = 480 * MiB;
constexpr int LDS_BYTES = 147456;
constexpr int LDS_MISC = 135168;
constexpr int NWAVES = 8, NTHREADS = 512;
constexpr int REP_P0 = 1, REP_P1 = 1, REP_P2 = 1, REP_P3A = 1, REP_SYNC = 1, REP_P3B = 1, REP_FIN = 1;

__device__ __forceinline__ unsigned f2bf(float f) { unsigned u = __builtin_bit_cast(unsigned, f); return (u + 0x7fffu + ((u >> 16) & 1u)) >> 16; }
__device__ __forceinline__ unsigned pk2(float lo, float hi) { return f2bf(lo) | (f2bf(hi) << 16); }
typedef float f32x2_t __attribute__((ext_vector_type(2))); typedef __bf16 bf16x2_t __attribute__((ext_vector_type(2)));
__device__ __forceinline__ unsigned cvtpk(float lo, float hi) { f32x2_t v = {lo, hi}; bf16x2_t b = __builtin_convertvector(v, bf16x2_t); return __builtin_bit_cast(unsigned, b); }
__device__ __forceinline__ float bflo(unsigned u) { return __uint_as_float(u << 16); }
__device__ __forceinline__ float bfhi(unsigned u) { return __uint_as_float(u & 0xffff0000u); }
__device__ __forceinline__ float wave_sum(float v) {
#pragma unroll
    for (int o = 1; o < 64; o <<= 1) v += __shfl_xor(v, o);
    return v;
}
#define LDS_WAIT() asm volatile("s_waitcnt lgkmcnt(0)" ::: "memory")

__device__ __forceinline__ void tr_item(const float* W, int ldw, bf16* WT, int ldt, int k0, int n0, int trow0, int tcol0, LAS float* scr, int lane) {
#pragma unroll 8
    for (int i = 0; i < 32; ++i) { const int kk = 2 * i + (lane >> 5); scr[kk * 33 + (lane & 31)] = W[(size_t)(k0 + kk) * ldw + n0 + (lane & 31)]; }
    LDS_WAIT();
    const int c = lane & 7;
#pragma unroll
    for (int j = 0; j < 4; ++j) { const int n = (lane >> 3) + 8 * j; const LAS float* s = scr + (8 * c) * 33 + n;
        v4u o; o.x = pk2(s[0 * 33], s[1 * 33]); o.y = pk2(s[2 * 33], s[3 * 33]); o.z = pk2(s[4 * 33], s[5 * 33]); o.w = pk2(s[6 * 33], s[7 * 33]);
        *(v4u*)(WT + (size_t)(trow0 + n) * ldt + tcol0 + 8 * c) = o; }
    LDS_WAIT();
}

#define RLX_AGENT __ATOMIC_RELAXED, __HIP_MEMORY_SCOPE_AGENT
#define XB_TMO      128
#define XB_XCNT(j)  (256  + 64 * (j))
#define XB_XSUB(j)  (1280 + 64 * (j))
#define XB_XGEN(j)  (2304 + 64 * (j))
#define XB_TOP      3328
#define XB_TOPGEN   3392
#define XCD_BAR_WORDS 3456
#define XB_SPIN_CAP (1u << 18)

__device__ __forceinline__ unsigned xb_ld(unsigned* p)              { return __hip_atomic_load(p, __ATOMIC_RELAXED, __HIP_MEMORY_SCOPE_AGENT); }
__device__ __forceinline__ unsigned xb_add(unsigned* p, unsigned v) { return __hip_atomic_fetch_add(p, v, __ATOMIC_RELAXED, __HIP_MEMORY_SCOPE_AGENT); }
__device__ __forceinline__ unsigned xb_xcc_id() { return (unsigned)__builtin_amdgcn_s_getreg((3 << 11) | 20) & 0xFu; }
#define XB_SPIN(cond, bar) do { unsigned _sp = 0; while (cond) { __builtin_amdgcn_s_sleep(1); \
    if ((++_sp & 255u) == 0u) { if (xb_ld(&(bar)[XB_TMO])) break; if (_sp > XB_SPIN_CAP) { atomicAdd(&(bar)[XB_TMO], 1u); break; } } } } while (0)

struct XcdBarrier {
    unsigned* bar; unsigned x;
    volatile LAS unsigned* st;
};

__device__ __forceinline__ XcdBarrier xcd_barrier_post(unsigned* bar, volatile LAS unsigned* st) {
    XcdBarrier b; b.bar = bar; b.x = xb_xcc_id(); b.st = st;
    if (threadIdx.x == 0) (void)xb_add(&bar[XB_XCNT(b.x)], 1u);
    return b;
}
__device__ __forceinline__ void xcd_barrier_complete(unsigned* bar, unsigned x, unsigned& nloc, unsigned& nx) {
    const unsigned G = gridDim.x * gridDim.y * gridDim.z;
    unsigned sum, cnt, mine, sp = 0u;
    for (;;) {
        sum = 0u; cnt = 0u; mine = 0u;
#pragma unroll
        for (unsigned j = 0; j < 16; ++j) { const unsigned c = xb_ld(&bar[XB_XCNT(j)]); sum += c; cnt += (c > 0u) ? 1u : 0u; mine = (j == x) ? c : mine; }
        if (sum == G) break;
        __builtin_amdgcn_s_sleep(1);
        if ((++sp & 255u) == 0u) { if (xb_ld(&bar[XB_TMO])) break; if (sp > XB_SPIN_CAP) { atomicAdd(&bar[XB_TMO], 1u); break; } }
    }
    nloc = mine > 0u ? mine : 1u; nx = cnt > 0u ? cnt : 1u;
}

__device__ __forceinline__ void xcd_barrier(const XcdBarrier& b) {
    asm volatile("s_waitcnt vmcnt(0)" ::: "memory");
    __syncthreads();
    if (threadIdx.x == 0) {
        unsigned* bar = b.bar;
        __builtin_amdgcn_s_waitcnt(0);
        unsigned nloc = b.st[0], nx = b.st[1];
        if (nloc == 0u) { xcd_barrier_complete(bar, b.x, nloc, nx); b.st[0] = nloc; b.st[1] = nx; }
        const unsigned old = xb_add(&bar[XB_XSUB(b.x)], 1u);
        const unsigned gen = old / nloc;
        if (old + 1u == (gen + 1u) * nloc) {
            __builtin_amdgcn_fence(__ATOMIC_RELEASE, "agent");
            asm volatile("s_waitcnt vmcnt(0)" ::: "memory");
            const unsigned og = xb_add(&bar[XB_TOP], 1u);
            const unsigned tg = og / nx;
            if (og + 1u == (tg + 1u) * nx) xb_add(&bar[XB_TOPGEN], 1u);
            else XB_SPIN(xb_ld(&bar[XB_TOPGEN]) == tg, bar);
            __builtin_amdgcn_fence(__ATOMIC_ACQUIRE, "agent");
            xb_add(&bar[XB_XGEN(b.x)], 1u);
            asm volatile("s_waitcnt vmcnt(0)" ::: "memory");
        } else {
            XB_SPIN(xb_ld(&bar[XB_XGEN(b.x)]) == gen, bar);
            __builtin_amdgcn_fence(__ATOMIC_ACQUIRE, "agent");
            asm volatile("s_waitcnt vmcnt(0)" ::: "memory");
        }
    }
    __syncthreads();
}
constexpr int VPITCH = 144;
constexpr float SB_EXIT = 1.17549435e-38f;
__device__ __forceinline__ int crow(int r, int hi) { return (r & 3) + 8 * (r >> 2) + 4 * hi; }
__device__ __forceinline__ s16x4 vtr(const LAS unsigned char* p) { typedef short v4i16_t __attribute__((ext_vector_type(4)));
    return __builtin_bit_cast(s16x4, __builtin_amdgcn_ds_read_tr16_b64_v4i16((LAS v4i16_t*)p)); }
__device__ __forceinline__ void attn_unit(const bf16* __restrict__ Q, const bf16* __restrict__ K, const bf16* __restrict__ V, const bf16* __restrict__ ZA, bf16* __restrict__ Y,
                                          int b, int h, int qt, LAS unsigned char* vl, int lane) {
    const int j = lane & 31, hi = lane >> 5;
    const size_t row0 = (size_t)b * SEQ + (size_t)qt * 32;
    const bf16* qp = Q + (row0 + j) * 512 + h * 64 + 8 * hi;
    bf16x8 qf[4];
#pragma unroll
    for (int s = 0; s < 4; ++s) qf[s] = *(const bf16x8*)(qp + 16 * s);
    f32x16 o0, o1;
#pragma unroll
    for (int r = 0; r < 16; ++r) { o0[r] = 0.f; o1[r] = 0.f; }
    float pc = 1.0f;
    const int blk = (lane >> 4) & 1, q4 = (lane & 15) >> 2, p4 = lane & 3;
    const unsigned trb = (unsigned)((4 * hi + q4) * VPITCH + (16 * blk + 4 * p4) * 2);
    const unsigned vwb = (unsigned)((lane >> 3) * VPITCH + (lane & 7) * 16);
    const bf16* kp = K + ((size_t)b * SEQ + (size_t)qt * 32 + j) * 512 + h * 64 + 8 * hi;
    const bf16* vp = V + ((size_t)b * SEQ + (size_t)qt * 32 + (lane >> 3)) * 512 + h * 64 + (lane & 7) * 8;
    bf16x8 kf[4], kfn[4]; v4u vv[4], vvn[4];
#pragma unroll
    for (int s = 0; s < 4; ++s) kf[s] = *(const bf16x8*)(kp + 16 * s);
#pragma unroll
    for (int i = 0; i < 4; ++i) vv[i] = *(const v4u*)(vp + (size_t)i * 8 * 512);
    for (int kt = qt; kt >= 0; --kt) {
        if (kt > 0) {
            kp -= 32 * 512; vp -= 32 * 512;
#pragma unroll
            for (int s = 0; s < 4; ++s) kfn[s] = *(const bf16x8*)(kp + 16 * s);
#pragma unroll
            for (int i = 0; i < 4; ++i) vvn[i] = *(const v4u*)(vp + (size_t)i * 8 * 512);
        }
        f32x16 sc;
#pragma unroll
        for (int r = 0; r < 16; ++r) sc[r] = 0.f;
#pragma unroll
        for (int s = 0; s < 4; ++s) sc = __builtin_amdgcn_mfma_f32_32x32x16_bf16(kf[s], qf[s], sc, 0, 0, 0);
        asm volatile("" ::: "memory");
#pragma unroll
        for (int i = 0; i < 4; ++i) *(LAS v4u*)(vl + vwb + i * 8 * VPITCH) = vv[i];
        asm volatile("" ::: "memory");
        const bool diag = (kt == qt);
        float be[16], om[16];
#pragma unroll
        for (int r = 0; r < 16; ++r) { const float e = __builtin_amdgcn_exp2f(-__builtin_fmaxf(sc[r], -126.0f)); const float bb = __builtin_amdgcn_rcpf(1.0f + e);
            be[r] = bb; om[r] = e * bb; }
        if (diag) {
#pragma unroll
            for (int r = 0; r < 16; ++r) if (crow(r, hi) >= j) { be[r] = 0.f; om[r] = 1.0f; } }
        float Rp[4], Tt[4];
#pragma unroll
        for (int a = 0; a < 4; ++a) { const float R = (om[4 * a] * om[4 * a + 1]) * (om[4 * a + 2] * om[4 * a + 3]); Rp[a] = __shfl_xor(R, 32); Tt[a] = R * Rp[a]; }
        float suf = pc; float w[16];
#pragma unroll
        for (int a = 3; a >= 0; --a) { float c = (hi == 0) ? suf * Rp[a] : suf;
            w[4 * a + 3] = be[4 * a + 3] * c; c *= om[4 * a + 3];
            w[4 * a + 2] = be[4 * a + 2] * c; c *= om[4 * a + 2];
            w[4 * a + 1] = be[4 * a + 1] * c; c *= om[4 * a + 1];
            w[4 * a] = be[4 * a] * c;
            suf *= Tt[a]; }
        pc = suf;
        bf16x8 pf[2];
#pragma unroll
        for (int s = 0; s < 2; ++s) { v4u p; p.x = cvtpk(w[8 * s], w[8 * s + 1]); p.y = cvtpk(w[8 * s + 2], w[8 * s + 3]); p.z = cvtpk(w[8 * s + 4], w[8 * s + 5]); p.w = cvtpk(w[8 * s + 6], w[8 * s + 7]);
            pf[s] = __builtin_bit_cast(bf16x8, p); }
#pragma unroll
        for (int s = 0; s < 2; ++s) {
            { const s16x4 lo = vtr(vl + trb + (16 * s) * VPITCH), hh = vtr(vl + trb + (16 * s + 8) * VPITCH);
              const bf16x8 vf = (bf16x8){lo[0], lo[1], lo[2], lo[3], hh[0], hh[1], hh[2], hh[3]};
              o0 = __builtin_amdgcn_mfma_f32_32x32x16_bf16(vf, pf[s], o0, 0, 0, 0); }
            { const s16x4 lo = vtr(vl + trb + (16 * s) * VPITCH + 64), hh = vtr(vl + trb + (16 * s + 8) * VPITCH + 64);
              const bf16x8 vf = (bf16x8){lo[0], lo[1], lo[2], lo[3], hh[0], hh[1], hh[2], hh[3]};
              o1 = __builtin_amdgcn_mfma_f32_32x32x16_bf16(vf, pf[s], o1, 0, 0, 0); }
        }
        asm volatile("" ::: "memory");
        if (__ballot(pc >= SB_EXIT) == 0ull) break;
#pragma unroll
        for (int s = 0; s < 4; ++s) { kf[s] = kfn[s]; vv[s] = vvn[s]; }
    }
    const size_t zrow = (row0 + j) * 512 + h * 64, yrow = (row0 + j) * 1024 + 512 + h * 64;
#pragma unroll
    for (int a = 0; a < 4; ++a) { const int d0 = 8 * a + 4 * hi;
        { const v2u zz = *(const v2u*)(ZA + zrow + d0); v2u o; o.x = cvtpk(o0[4 * a] * bflo(zz.x), o0[4 * a + 1] * bfhi(zz.x)); o.y = cvtpk(o0[4 * a + 2] * bflo(zz.y), o0[4 * a + 3] * bfhi(zz.y));
          *(v2u*)(Y + yrow + d0) = o; }
        { const v2u zz = *(const v2u*)(ZA + zrow + 32 + d0); v2u o; o.x = cvtpk(o1[4 * a] * bflo(zz.x), o1[4 * a + 1] * bfhi(zz.x)); o.y = cvtpk(o1[4 * a + 2] * bflo(zz.y), o1[4 * a + 3] * bfhi(zz.y));
          *(v2u*)(Y + yrow + 32 + d0) = o; } }
}

__device__ __forceinline__ void unpack8(const v4u q, float (&f)[8]) { f[0] = bflo(q.x); f[1] = bfhi(q.x); f[2] = bflo(q.y); f[3] = bfhi(q.y); f[4] = bflo(q.z); f[5] = bfhi(q.z); f[6] = bflo(q.w); f[7] = bfhi(q.w); }
template <int W> __device__ __forceinline__ void pool_wave_task(const bf16* __restrict__ VP, const bf16* __restrict__ ZP, bf16* __restrict__ Y, int g, int tblk, int lane) {
    const int t0 = tblk * 32 + (lane >> 4) * 8, pos0 = t0 & (SEQ - 1), ch = g * 128 + (lane & 15) * 8;
    const bf16* vp = VP + (size_t)t0 * 512 + ch; const bf16* zp = ZP + (size_t)t0 * 512 + ch; bf16* yp = Y + (size_t)t0 * 1024 + ch;
    v4u hv[W + 7], zv[8];
#pragma unroll
    for (int i = 0; i < W + 7; ++i) { const int off = i - (W - 1); hv[i] = (pos0 + off >= 0) ? *(const v4u*)(vp + (ptrdiff_t)off * 512) : (v4u){0u, 0u, 0u, 0u}; }
#pragma unroll
    for (int t = 0; t < 8; ++t) zv[t] = *(const v4u*)(zp + (size_t)t * 512);
    float s[8];
#pragma unroll
    for (int e = 0; e < 8; ++e) s[e] = 0.f;
#pragma unroll
    for (int i = 0; i < W - 1; ++i) { float f[8]; unpack8(hv[i], f);
#pragma unroll
        for (int e = 0; e < 8; ++e) s[e] += f[e]; }
#pragma unroll
    for (int t = 0; t < 8; ++t) { float v[8], z[8], y[8]; unpack8(hv[W - 1 + t], v); unpack8(zv[t], z);
        const int cnt = (pos0 + t + 1 < W) ? pos0 + t + 1 : W; const float inv = __builtin_amdgcn_rcpf((float)cnt);
#pragma unroll
        for (int e = 0; e < 8; ++e) { s[e] += v[e]; y[e] = (s[e] * inv - v[e]) * z[e]; }
        v4u o; o.x = cvtpk(y[0], y[1]); o.y = cvtpk(y[2], y[3]); o.z = cvtpk(y[4], y[5]); o.w = cvtpk(y[6], y[7]);
        *(v4u*)(yp + (size_t)t * 1024) = o;
        float f[8]; unpack8(hv[t], f);
#pragma unroll
        for (int e = 0; e < 8; ++e) s[e] -= f[e]; }
}

struct Args { const float* in[10]; float* out; unsigned char* ws; };
__global__ void __launch_bounds__(NTHREADS, 2) fwd_megakernel(Args args) {
    extern __shared__ __attribute__((aligned(16))) unsigned char lds_raw[];
    LAS unsigned char* lds = (LAS unsigned char*)lds_raw;
    cg::grid_group grid = cg::this_grid();
    const int tid = threadIdx.x, lane = tid & 63, wave = __builtin_amdgcn_readfirstlane(tid >> 6);
    const int G = gridDim.x, bx = blockIdx.x, vcu = (G % 8 == 0) ? (bx % 8) * (G / 8) + bx / 8 : bx;
    const int gw = vcu * NWAVES + wave, NGW = G * NWAVES;
    volatile LAS unsigned* MISC = (volatile LAS unsigned*)(lds + LDS_MISC);
    if (tid < 4) MISC[tid] = 0u;
    __syncthreads();
    const XcdBarrier bar = xcd_barrier_post((unsigned*)(args.ws + WS_BAR), MISC);
    const float* x = args.in[0]; const float* norm_g = args.in[1]; const float* w_in = args.in[2]; const float* b_gate = args.in[3]; const float* pool_w = args.in[4];
    const float* pool_scale = args.in[5]; const float* w_pool_up = args.in[6]; const float* w_attn_up = args.in[7]; const float* w_out = args.in[8]; const float* final_g = args.in[9];
    float* out = args.out; unsigned char* ws = args.ws;
    float* SSP = (float*)(ws + WS_SSP);
    bf16* XG = (bf16*)(ws + WS_XG); bf16* VP = (bf16*)(ws + WS_VP); bf16* ZP = (bf16*)(ws + WS_ZP); bf16* Qb = (bf16*)(ws + WS_Q); bf16* Kb = (bf16*)(ws + WS_K);
    bf16* Vb = (bf16*)(ws + WS_V); bf16* ZA = (bf16*)(ws + WS_ZA); bf16* Gt = (bf16*)(ws + WS_G); bf16* Yb = (bf16*)(ws + WS_Y); bf16* MG = (bf16*)(ws + WS_MG);

#pragma nounroll
    for (int rep = 0; rep < REP_P0; ++rep) {
        LAS float* PW = (LAS float*)lds; LAS float* WI = (LAS float*)(lds + 65536);
        for (int it = vcu; it < 256; it += G) {
            const int l = it >> 7, g = (it >> 5) & 3, k0 = (it & 31) * 32;
            const float* pw = pool_w + ((size_t)l * 4 + g) * 16384; const float* wi = w_in + (size_t)l * DM * NIN + (size_t)k0 * NIN + g * 128;
            __syncthreads();
#pragma unroll 4
            for (int i = 0; i < 32; ++i) PW[tid + 512 * i] = pw[tid + 512 * i];
#pragma unroll
            for (int i = 0; i < 8; ++i) { const int idx = tid + 512 * i; WI[idx] = wi[(size_t)(idx >> 7) * NIN + (idx & 127)]; }
            __syncthreads();
            const int d = tid & 127, kq = tid >> 7; float acc[8];
#pragma unroll
            for (int e = 0; e < 8; ++e) acc[e] = 0.f;
            for (int c = 0; c < 128; ++c) { const float p = PW[c * 128 + d];
#pragma unroll
                for (int e = 0; e < 8; ++e) acc[e] += WI[(kq * 8 + e) * 128 + c] * p; }
            const float sc = pool_scale[l * 512 + g * 128 + d];
            v4u o; o.x = pk2(acc[0] * sc, acc[1] * sc); o.y = pk2(acc[2] * sc, acc[3] * sc); o.z = pk2(acc[4] * sc, acc[5] * sc); o.w = pk2(acc[6] * sc, acc[7] * sc);
            bf16* wt = (bf16*)(ws + WS_W + (size_t)l * W_LAYER);
            *(v4u*)(wt + (size_t)(g * 128 + d) * 1024 + k0 + kq * 8) = o;
        }
        __syncthreads();
        LAS float* scr = (LAS float*)(lds + wave * 16384);
        for (int it = gw; it < 6656; it += NGW) {
            const int l = it / 3328; int r = it % 3328;
            bf16* win_t = (bf16*)(ws + WS_W + (size_t)l * W_LAYER); bf16* wpa_t = win_t + (size_t)NIN * 1024; bf16* wout_t = wpa_t + (size_t)1024 * 1024;
            if (r < 2304) { const int kb = r / 144, nb = r % 144; tr_item(w_in + (size_t)l * DM * NIN, NIN, win_t, 1024, kb * 64, 512 + nb * 32, 512 + nb * 32, kb * 64, scr, lane); continue; } r -= 2304;
            if (r < 256) { const int kb = r / 32, nb = r % 32; tr_item(w_pool_up + (size_t)l * 512 * 1024, 1024, wpa_t, 1024, kb * 64, nb * 32, nb * 32, kb * 64, scr, lane); continue; } r -= 256;
            if (r < 256) { const int kb = r / 32, nb = r % 32; tr_item(w_attn_up + (size_t)l * 512 * 1024, 1024, wpa_t, 1024, kb * 64, nb * 32, nb * 32, 512 + kb * 64, scr, lane); continue; } r -= 256;
            { const int kb = r / 32, nb = r % 32; tr_item(w_out + (size_t)l * 1024 * 1024, 1024, wout_t, 1024, kb * 64, nb * 32, nb * 32, kb * 64, scr, lane); }
        }
        for (int m = gw; m < T; m += NGW) {
            const f32x4* xr = (const f32x4*)(x + (size_t)m * DM) + lane; const f32x4* gr = (const f32x4*)norm_g + lane;
            f32x4 v[4]; float s = 0.f;
#pragma unroll
            for (int jx = 0; jx < 4; ++jx) { v[jx] = xr[64 * jx]; s += (v[jx][0] * v[jx][0] + v[jx][1] * v[jx][1]) + (v[jx][2] * v[jx][2] + v[jx][3] * v[jx][3]); }
            s = wave_sum(s);
            v2u* o8 = (v2u*)(XG + (size_t)m * DM) + lane;
#pragma unroll
            for (int jx = 0; jx < 4; ++jx) { const f32x4 gg = gr[64 * jx]; v2u o; o.x = pk2(v[jx][0] * gg[0], v[jx][1] * gg[1]); o.y = pk2(v[jx][2] * gg[2], v[jx][3] * gg[3]); o8[64 * jx] = o; }
            if (lane < 16) SSP[(size_t)m * 16 + lane] = (lane == 0) ? s : 0.f;
        }
    }
    grid.sync();

    for (int l = 0; l < 2; ++l) {
        const bf16* win_t = (const bf16*)(ws + WS_W + (size_t)l * W_LAYER); const bf16* wpa_t = win_t + (size_t)NIN * 1024; const bf16* wout_t = wpa_t + (size_t)1024 * 1024;
#pragma nounroll
        for (int rep = 0; rep < REP_P1; ++rep) {   pg8::Gemm g{XG, win_t, T, NIN, DM, DM, DM}; pg8::StaticOrder S; S.init(T, NIN, G, bx);
            pg8::EpiProj E{VP, ZP, Qb, Kb, Vb, ZA, Gt, SSP, b_gate + l * 2048};
            pg8::gemm_phase<pg8::EpiProj, pg8::StaticOrder, true, true>(lds, g, S, E); }
#pragma nounroll
        for (int rep = 0; rep < REP_SYNC; ++rep) xcd_barrier(bar);
#pragma nounroll
        for (int rep = 0; rep < REP_P2; ++rep) {   LAS unsigned char* vl = lds + wave * 8192;
            int ln = lane; asm volatile("" : "+v"(ln));
            for (int u = gw; u < NB * NH * (SEQ / 32); u += NGW) { const int qt = u & 255, bh = u >> 8; attn_unit(Qb, Kb, Vb, ZA, Yb, bh >> 3, bh & 7, qt, vl, ln); }
            for (int wt = gw; wt < (T / 32) * 4; wt += NGW) { const int g = wt & 3, tblk = wt >> 2;
                if (g == 0) pool_wave_task<2>(VP, ZP, Yb, 0, tblk, ln); else if (g == 1) pool_wave_task<4>(VP, ZP, Yb, 1, tblk, ln);
                else if (g == 2) pool_wave_task<8>(VP, ZP, Yb, 2, tblk, ln); else pool_wave_task<16>(VP, ZP, Yb, 3, tblk, ln); } }
        xcd_barrier(bar);
#pragma nounroll
        for (int rep = 0; rep < REP_P3A; ++rep) {   pg8::StaticOrder S; S.init(T, DM, G, bx);
            { pg8::Gemm g{Yb, wpa_t, T, DM, 512, 1024, 1024}; pg8::EpiMerge<0> E{MG, Gt}; pg8::gemm_phase<pg8::EpiMerge<0>, pg8::StaticOrder, true, true>(lds, g, S, E); }
            { pg8::Gemm g{Yb + 512, wpa_t + 512, T, DM, 512, 1024, 1024}; pg8::EpiMerge<1> E{MG, Gt}; pg8::gemm_phase<pg8::EpiMerge<1>, pg8::StaticOrder, true, true>(lds, g, S, E); } }
        xcd_barrier(bar);
#pragma nounroll
        for (int rep = 0; rep < (l == 0 ? REP_P3B : 1); ++rep) {   pg8::Gemm g{MG, wout_t, T, DM, DM, DM, DM}; pg8::StaticOrder S; S.init(T, DM, G, bx);
            pg8::EpiOut E{l == 0 ? x : (const float*)out, out, XG, norm_g + 1024, SSP, l == 0 ? 1 : 0};
            pg8::gemm_phase<pg8::EpiOut, pg8::StaticOrder, true, true>(lds, g, S, E); }
        xcd_barrier(bar);
    }
#pragma nounroll
    for (int rep = 0; rep < REP_FIN; ++rep)
    for (int m = gw; m < T; m += NGW) {
        float ss = SSP[(size_t)m * 16 + (lane & 15)];
        ss += __shfl_xor(ss, 1); ss += __shfl_xor(ss, 2); ss += __shfl_xor(ss, 4); ss += __shfl_xor(ss, 8);
        const float rstd = __builtin_amdgcn_rsqf(ss * (1.0f / 1024.0f) + 1e-6f);
        f32x4* xr = (f32x4*)(out + (size_t)m * DM) + lane; const f32x4* gr = (const f32x4*)final_g + lane;
        f32x4* xw = (rep == REP_FIN - 1) ? xr : (f32x4*)((float*)(ws + WS_G) + (size_t)m * DM) + lane;
#pragma unroll
        for (int jx = 0; jx < 4; ++jx) { const f32x4 v = xr[64 * jx]; xw[64 * jx] = v * rstd * gr[64 * jx]; }
    }
}

extern "C" void kernel_launch(void* const* d_in, const int* in_sizes, int n_in, void* d_out, int out_size, void* d_ws, size_t ws_size, hipStream_t stream) {
    static int grid = 0;
    if (grid == 0) {
        if (n_in != 10 || in_sizes[0] != T * DM || out_size != T * DM || ws_size < WS_END) { fprintf(stderr, "kernel_launch: unexpected shapes / workspace (ws %zu, need %zu)\n", ws_size, (size_t)WS_END); grid = -1; return; }
        int dev = 0, cus = 0, per_cu = 0;
        hipGetDevice(&dev); hipDeviceGetAttribute(&cus, hipDeviceAttributeMultiprocessorCount, dev);
        hipFuncSetAttribute((const void*)fwd_megakernel, hipFuncAttributeMaxDynamicSharedMemorySize, LDS_BYTES);
        hipOccupancyMaxActiveBlocksPerMultiprocessor(&per_cu, (const void*)fwd_megakernel, NTHREADS, LDS_BYTES);
        if (per_cu < 1) { fprintf(stderr, "kernel_launch: occupancy query says %d blocks per CU\n", per_cu); per_cu = 1; }
        grid = cus * per_cu;
    }
    if (grid < 0) return;
    if (hipMemsetAsync((char*)d_ws + WS_BAR, 0, BAR_ZERO_BYTES, stream) != hipSuccess) { fprintf(stderr, "kernel_launch: memset of the barrier words failed\n"); return; }
    Args a{};
    for (int i = 0; i < 10; ++i) a.in[i] = (const float*)d_in[i];
    a.out = (float*)d_out; a.ws = (unsigned char*)d_ws;
    void* kargs[] = {&a};
    hipError_t e = hipLaunchCooperativeKernel((const void*)fwd_megakernel, dim3(grid), dim3(NTHREADS), kargs, LDS_BYTES, stream);
    if (e != hipSuccess) fprintf(stderr, "cooperative launch failed: %s (grid %d)\n", hipGetErrorString(e), grid);
}
```

```cpp
#include <hip/hip_runtime.h>
#include <hip/hip_cooperative_groups.h>
#include <cstdio>
#include <cstdint>
namespace cg = cooperative_groups;
namespace pg8 {
#define PG8_LAS __attribute__((address_space(3)))
typedef unsigned short bf16_t;
typedef short bf16x8 __attribute__((ext_vector_type(8)));
typedef float f32x4 __attribute__((ext_vector_type(4)));
typedef unsigned u32x4 __attribute__((ext_vector_type(4)));
constexpr int BM = 256, BK = 64, HALF = 128, HTB = HALF * BK * 2  , STAGE_BYTES = 8 * HTB, NXCD = 8, WGM = 8;

__host__ __device__ __forceinline__ int lds_byte(int r, int c) { const int st = (r >> 4) * 2 + (c >> 5), rr = r & 15, cc = c & 31, ob = rr * 64 + cc * 2; return st * 1024 + (ob ^ (((ob >> 9) & 1) << 5)); }
__host__ __device__ __forceinline__ void stage_rc(int b, int& R, int& C) { const int st = b / 1024, sb = b % 1024, swz = sb ^ (((sb >> 9) & 1) << 5); R = (st >> 1) * 16 + swz / 64; C = (st & 1) * 32 + (swz % 64) / 2; }
__host__ __device__ __forceinline__ int perm32(int rho) { const int n = rho >> 4, i = rho & 15; return 8 * (i >> 2) + 4 * n + (i & 3); }

struct Unit { int pm, pn; };
struct Gemm { const bf16_t* A; const bf16_t* Bt; int M, N, K, lda, ldb; };

struct StaticOrder {
    int nM, nN, nwg, G, c;
    __host__ __device__ void init(int M, int N, int G_, int c_) { nM = M / BM; nN = N / BM; nwg = nM * nN; G = G_; c = c_; }
    __host__ __device__ bool next(int i, Unit& u) const {
        const long L = (long)i * G + c; if (L >= nwg) return false;
        int wgid = (int)L; { const int q = nwg / NXCD, r = nwg % NXCD, xcd = wgid % NXCD, off = wgid / NXCD; wgid = (xcd < r ? xcd * (q + 1) : r * (q + 1) + (xcd - r) * q) + off; }
        const int nig = WGM * nN, gid = wgid / nig, fm = gid * WGM, gsz = (nM - fm) < WGM ? (nM - fm) : WGM;
        u.pm = fm + ((wgid % nig) % gsz); u.pn = (wgid % nig) / gsz; return true;
    }
    __device__ __forceinline__ void a_ready(const Unit&) const {}
    __device__ __forceinline__ void done(const Unit&) const {}
};

__device__ __forceinline__ unsigned cvt_pk_bf16(float lo, float hi) { unsigned r; asm volatile("v_cvt_pk_bf16_f32 %0, %1, %2" : "=v"(r) : "v"(lo), "v"(hi)); return r; }
typedef float f32x2 __attribute__((ext_vector_type(2)));
__device__ __forceinline__ float bf_lo(unsigned u) { return __uint_as_float(u << 16); }
__device__ __forceinline__ float bf_hi(unsigned u) { return __uint_as_float(u & 0xffff0000u); }
__device__ __forceinline__ float sigmoid_f(float v) { return __builtin_amdgcn_rcpf(1.0f + __builtin_amdgcn_exp2f(-1.4426950408889634f * v)); }
constexpr float RMS_EPS_F = 1e-6f;
constexpr float QSCALE = 0.125f * 1.4426950408889634f;

struct EpiProj {
    static constexpr bool PERM = true, AFTER_DRAIN = false;
    bf16_t *VP, *ZP, *Q, *K, *V, *ZA, *G; const float* ssp; const float* bgate;
    __device__ __forceinline__ void operator()(const f32x4 (&acc)[2][2][4][2], const Unit& u, int wr, int wc, int fr, int fq) const {
        const int pn = u.pn; bf16_t* base; int ld, mode, colt; float sc = 1.f;
        if (pn < 12) { const int seg = pn >> 1; colt = (pn & 1) * 256; ld = 512;
            base = seg == 0 ? VP : seg == 1 ? ZP : seg == 2 ? Q : seg == 3 ? K : seg == 4 ? V : ZA;
            mode = (seg == 1 || seg == 5) ? 1 : 0; if (seg == 2) sc = QSCALE; }
        else { base = G; colt = (pn - 12) * 256; ld = 2048; mode = 2; }
        const int row0 = u.pm * BM + wr * 64 + fr, col0 = colt + wc * 32 + 8 * fq;
        f32x4 bv[2][2];
#pragma unroll
        for (int bj = 0; bj < 2; ++bj)
#pragma unroll
            for (int n = 0; n < 2; ++n) bv[bj][n] = (mode == 2) ? *(const f32x4*)(bgate + col0 + bj * HALF + 4 * n) : (f32x4){0.f, 0.f, 0.f, 0.f};
#pragma unroll
        for (int ai = 0; ai < 2; ++ai)
#pragma unroll
            for (int m = 0; m < 4; ++m) { const int row = row0 + ai * HALF + m * 16;
                const f32x4 st = *((const f32x4*)(ssp + (size_t)row * 16) + fq);
                float ss = (st[0] + st[1]) + (st[2] + st[3]); ss += __shfl_xor(ss, 16); ss += __shfl_xor(ss, 32);
                const float rstd = __builtin_amdgcn_rsqf(ss * (1.0f / 1024.0f) + RMS_EPS_F) * sc;
                bf16_t* rowp = base + (size_t)row * ld + col0;
#pragma unroll
                for (int bj = 0; bj < 2; ++bj) { f32x4 v0 = acc[ai][bj][m][0] * rstd, v1 = acc[ai][bj][m][1] * rstd;
                    if (mode == 2) { v0 = v0 + bv[bj][0]; v1 = v1 + bv[bj][1];
#pragma unroll
                        for (int e = 0; e < 4; ++e) { v0[e] = sigmoid_f(v0[e]); v1[e] = sigmoid_f(v1[e]); } }
                    else if (mode == 1) {
#pragma unroll
                        for (int e = 0; e < 4; ++e) { v0[e] = v0[e] * sigmoid_f(v0[e]); v1[e] = v1[e] * sigmoid_f(v1[e]); } }
                    u32x4 w; w.x = cvt_pk_bf16(v0[0], v0[1]); w.y = cvt_pk_bf16(v0[2], v0[3]); w.z = cvt_pk_bf16(v1[0], v1[1]); w.w = cvt_pk_bf16(v1[2], v1[3]);
                    *(u32x4*)(rowp + bj * HALF) = w; } }
    }
};
template <int PASS> struct EpiMerge {
    static constexpr bool PERM = true, AFTER_DRAIN = false;
    bf16_t* MG; const bf16_t* G;
    __device__ __forceinline__ void operator()(const f32x4 (&acc)[2][2][4][2], const Unit& u, int wr, int wc, int fr, int fq) const {
        const int row0 = u.pm * BM + wr * 64 + fr, col0 = u.pn * BM + wc * 32 + 8 * fq;
#pragma unroll
        for (int ai = 0; ai < 2; ++ai)
#pragma unroll
            for (int m = 0; m < 4; ++m) { const int row = row0 + ai * HALF + m * 16;
#pragma unroll
                for (int bj = 0; bj < 2; ++bj) { const int col = col0 + bj * HALF;
                    const u32x4 gq = *(const u32x4*)(G + (size_t)row * 2048 + PASS * 1024 + col);
                    f32x4 v0 = acc[ai][bj][m][0], v1 = acc[ai][bj][m][1];
                    v0[0] *= bf_lo(gq.x); v0[1] *= bf_hi(gq.x); v0[2] *= bf_lo(gq.y); v0[3] *= bf_hi(gq.y);
                    v1[0] *= bf_lo(gq.z); v1[1] *= bf_hi(gq.z); v1[2] *= bf_lo(gq.w); v1[3] *= bf_hi(gq.w);
                    u32x4* mp = (u32x4*)(MG + (size_t)row * 1024 + col);
                    if (PASS == 1) { const u32x4 pq = *mp;
                        v0[0] += bf_lo(pq.x); v0[1] += bf_hi(pq.x); v0[2] += bf_lo(pq.y); v0[3] += bf_hi(pq.y);
                        v1[0] += bf_lo(pq.z); v1[1] += bf_hi(pq.z); v1[2] += bf_lo(pq.w); v1[3] += bf_hi(pq.w); }
                    u32x4 w; w.x = cvt_pk_bf16(v0[0], v0[1]); w.y = cvt_pk_bf16(v0[2], v0[3]); w.z = cvt_pk_bf16(v1[0], v1[1]); w.w = cvt_pk_bf16(v1[2], v1[3]);
                    *mp = w; } }
    }
};
struct EpiOut {
    static constexpr bool PERM = false, AFTER_DRAIN = false;
    const float* xin; float* xout; bf16_t* XG; const float* gnext; float* ssp; int write_xg;
    __device__ __forceinline__ void operator()(const f32x4 (&acc)[2][2][4][2], const Unit& u, int wr, int wc, int fr, int fq) const {
        typedef unsigned u32x2v __attribute__((ext_vector_type(2)));
        const int col0 = u.pn * BM + wc * 32 + 4 * fq;
#pragma unroll
        for (int ai = 0; ai < 2; ++ai)
#pragma unroll
            for (int m = 0; m < 4; ++m) { const int row = u.pm * BM + ai * HALF + wr * 64 + m * 16 + fr; const size_t off = (size_t)row * 1024 + col0; float ss = 0.f;
#pragma unroll
                for (int bj = 0; bj < 2; ++bj)
#pragma unroll
                    for (int n = 0; n < 2; ++n) { const int co = bj * HALF + n * 16;
                        const f32x4 v = *(const f32x4*)(xin + off + co) + acc[ai][bj][m][n];
                        *(f32x4*)(xout + off + co) = v; ss += (v[0] * v[0] + v[1] * v[1]) + (v[2] * v[2] + v[3] * v[3]);
                        if (write_xg) { const f32x4 gg = *(const f32x4*)(gnext + col0 + co); u32x2v w; w.x = cvt_pk_bf16(v[0] * gg[0], v[1] * gg[1]); w.y = cvt_pk_bf16(v[2] * gg[2], v[3] * gg[3]);
                            *(u32x2v*)(XG + off + co) = w; } }
                ss += __shfl_xor(ss, 16); ss += __shfl_xor(ss, 32);
                if (fq == 0) ssp[(size_t)row * 16 + u.pn * 4 + wc] = ss; }
    }
};
template <class Epi, class Sched, bool ALIGN_EPI = false, bool SP2 = false>
__device__ __forceinline__ void gemm_phase(PG8_LAS unsigned char* lds, const Gemm g_in, const Sched& S, const Epi& E) {
    Gemm g = g_in; asm volatile("" : "+s"(g.A), "+s"(g.Bt));
    int tid_ = threadIdx.x; asm volatile("" : "+v"(tid_));
    const int tid = tid_, wid = __builtin_amdgcn_readfirstlane(tid >> 6), lane = tid & 63, wr = wid >> 2, wc = wid & 3, fr = lane & 15, fq = lane >> 4;
    const int K = g.K, nt = K / BK;
    unsigned voffA[2], voffB[2];
#pragma unroll
    for (int i = 0; i < 2; ++i) { int R, C; stage_rc(tid * 16 + i * 8192, R, C); const int Rb = Epi::PERM ? ((R & ~31) + perm32(R & 31)) : R;
        voffA[i] = (unsigned)(R * g.lda + C) * 2u; voffB[i] = (unsigned)(Rb * g.ldb + C) * 2u; }
    const size_t kstep = (size_t)(BK * 2);
    const size_t hstepA = (size_t)HALF * g.lda * 2, hstepB = (size_t)HALF * g.ldb * 2;
    const size_t tstepA = 2 * hstepA, tstepB = 2 * hstepB;
    const unsigned ldsw = (unsigned)wid * 1024u;
    const int aoff = lds_byte(wr * 64 + fr, fq * 8), boff = lds_byte(wc * 32 + fr, fq * 8);
#define PG8_SA(b, h) (((b) * 2 + (h)) * HTB)
#define PG8_SB(b, h) ((4 + (b) * 2 + (h)) * HTB)
#define PG8_STAGE(bufoff, gbase, voff) do { _Pragma("unroll") for (int _i = 0; _i < 2; ++_i) \
        __builtin_amdgcn_global_load_lds((const unsigned*)((const char*)(gbase) + (voff)[_i]), (PG8_LAS unsigned*)(lds + (bufoff) + ldsw + _i * 8192), 16, 0, 0); } while (0)
#define PG8_LDA(dst, b, h) do { _Pragma("unroll") for (int m = 0; m < 4; ++m) _Pragma("unroll") for (int k = 0; k < 2; ++k) dst[m][k] = *(const PG8_LAS bf16x8*)(lds + PG8_SA(b, h) + aoff + m * 2048 + k * 1024); } while (0)
#define PG8_LDB(dst, b, h) do { _Pragma("unroll") for (int n = 0; n < 2; ++n) _Pragma("unroll") for (int k = 0; k < 2; ++k) dst[n][k] = *(const PG8_LAS bf16x8*)(lds + PG8_SB(b, h) + boff + n * 2048 + k * 1024); } while (0)
#define PG8_MMA(ai, bj, At, Bt) do { __builtin_amdgcn_s_setprio(1); _Pragma("unroll") for (int m = 0; m < 4; ++m) _Pragma("unroll") for (int n = 0; n < 2; ++n) _Pragma("unroll") for (int k = 0; k < 2; ++k) \
        acc[ai][bj][m][n] = __builtin_amdgcn_mfma_f32_16x16x32_bf16(Bt[n][k], At[m][k], acc[ai][bj][m][n], 0, 0, 0); __builtin_amdgcn_s_setprio(0); } while (0)
#define PG8_WAIT_V(n) asm volatile("s_waitcnt vmcnt(" #n ")" ::: "memory")
#define PG8_WAIT_L(n) asm volatile("s_waitcnt lgkmcnt(" #n ")" ::: "memory")
#define PG8_BAR __builtin_amdgcn_s_barrier()
#define PG8_SCHED __builtin_amdgcn_sched_barrier(0)
    Unit cur, nxt; int ui = 0;
    if (!S.next(0, cur)) return;
    f32x4 acc[2][2][4][2];
#pragma unroll
    for (int a = 0; a < 2; ++a)
#pragma unroll
        for (int b = 0; b < 2; ++b)
#pragma unroll
            for (int m = 0; m < 4; ++m)
#pragma unroll
                for (int n = 0; n < 2; ++n) acc[a][b][m][n] = (f32x4){0.f, 0.f, 0.f, 0.f};
    bf16x8 At[4][2], B0[2][2], B1[2][2];
    const char* cA = (const char*)g.A + (size_t)cur.pm * tstepA; const char* cB = (const char*)g.Bt + (size_t)cur.pn * tstepB;
    S.a_ready(cur);
    if constexpr (SP2) {
        PG8_STAGE(PG8_SB(0, 0), cB, voffB); PG8_STAGE(PG8_SB(0, 1), cB + hstepB, voffB); PG8_STAGE(PG8_SA(0, 0), cA, voffA); PG8_STAGE(PG8_SA(0, 1), cA + hstepA, voffA);
        if (wr == 1) PG8_BAR;
        PG8_WAIT_V(2); PG8_BAR;
        PG8_STAGE(PG8_SB(1, 0), cB + kstep, voffB); PG8_STAGE(PG8_SA(1, 0), cA + kstep, voffA); PG8_STAGE(PG8_SB(1, 1), cB + hstepB + kstep, voffB);
        PG8_WAIT_V(6); PG8_BAR;
    } else {
        PG8_STAGE(PG8_SB(0, 0), cB, voffB); PG8_STAGE(PG8_SA(0, 0), cA, voffA); PG8_STAGE(PG8_SB(0, 1), cB + hstepB, voffB); PG8_STAGE(PG8_SA(0, 1), cA + hstepA, voffA);
        if (wr == 1) PG8_BAR;
        PG8_WAIT_V(4); PG8_BAR;
        PG8_STAGE(PG8_SB(1, 0), cB + kstep, voffB); PG8_STAGE(PG8_SA(1, 0), cA + kstep, voffA); PG8_STAGE(PG8_SB(1, 1), cB + hstepB + kstep, voffB);
        PG8_WAIT_V(6); PG8_BAR;
    }
    for (;;) {
        const bool has_next = S.next(ui + 1, nxt);
        const char* nA = has_next ? (const char*)g.A + (size_t)nxt.pm * tstepA : cA; const char* nB = has_next ? (const char*)g.Bt + (size_t)nxt.pn * tstepB : cB;
        for (int t = 0; t < nt; t += 2) {
            const bool last = (t == nt - 2);
            const char* a1 = cA + (size_t)(t + 1) * kstep;
            const char* a2 = last ? nA : cA + (size_t)(t + 2) * kstep; const char* b2 = last ? nB : cB + (size_t)(t + 2) * kstep;
            const char* a3 = a2 + kstep; const char* b3 = b2 + kstep;
            if (last && has_next) S.a_ready(nxt);
            if constexpr (SP2) {
            PG8_LDB(B0, 0, 0); PG8_LDB(B1, 0, 1); PG8_SCHED; PG8_LDA(At, 0, 0); PG8_STAGE(PG8_SA(1, 1), a1 + hstepA, voffA);
            PG8_WAIT_V(8); PG8_WAIT_L(0); PG8_BAR; PG8_MMA(0, 0, At, B0); PG8_MMA(0, 1, At, B1); PG8_BAR; PG8_SCHED;
            PG8_LDA(At, 0, 1); PG8_STAGE(PG8_SB(0, 0), b2, voffB); PG8_STAGE(PG8_SB(0, 1), b2 + hstepB, voffB); PG8_STAGE(PG8_SA(0, 0), a2, voffA);
            PG8_WAIT_V(8); PG8_WAIT_L(0); PG8_BAR; PG8_MMA(1, 0, At, B0); PG8_MMA(1, 1, At, B1); PG8_BAR; PG8_SCHED;
            PG8_LDB(B0, 1, 0); PG8_LDB(B1, 1, 1); PG8_SCHED; PG8_LDA(At, 1, 0); PG8_STAGE(PG8_SA(0, 1), a2 + hstepA, voffA);
            PG8_WAIT_V(8); PG8_WAIT_L(0); PG8_BAR; PG8_MMA(0, 0, At, B0); PG8_MMA(0, 1, At, B1); PG8_BAR; PG8_SCHED;
            PG8_LDA(At, 1, 1); PG8_STAGE(PG8_SB(1, 0), b3, voffB); PG8_STAGE(PG8_SB(1, 1), b3 + hstepB, voffB); PG8_STAGE(PG8_SA(1, 0), a3, voffA);
            PG8_WAIT_V(8); PG8_WAIT_L(0); PG8_BAR; PG8_MMA(1, 0, At, B0); PG8_MMA(1, 1, At, B1); PG8_BAR; PG8_SCHED;
            } else {
            PG8_LDB(B0, 0, 0); PG8_SCHED; PG8_LDA(At, 0, 0); PG8_STAGE(PG8_SA(1, 1), a1 + hstepA, voffA);
            PG8_WAIT_L(8); PG8_BAR; PG8_WAIT_L(0); PG8_MMA(0, 0, At, B0); PG8_BAR; PG8_SCHED;
            PG8_LDB(B1, 0, 1); PG8_STAGE(PG8_SB(0, 0), b2, voffB);
            PG8_BAR; PG8_WAIT_L(0); PG8_MMA(0, 1, At, B1); PG8_BAR;
            PG8_LDA(At, 0, 1); PG8_STAGE(PG8_SA(0, 0), a2, voffA);
            PG8_BAR; PG8_WAIT_L(0); PG8_MMA(1, 0, At, B0); PG8_BAR; PG8_SCHED;
            PG8_STAGE(PG8_SB(0, 1), b2 + hstepB, voffB);
            PG8_WAIT_V(6); PG8_BAR; PG8_MMA(1, 1, At, B1); PG8_BAR;
            PG8_LDB(B0, 1, 0); PG8_SCHED; PG8_LDA(At, 1, 0); PG8_STAGE(PG8_SA(0, 1), a2 + hstepA, voffA);
            PG8_WAIT_L(8); PG8_BAR; PG8_WAIT_L(0); PG8_MMA(0, 0, At, B0); PG8_BAR; PG8_SCHED;
            PG8_LDB(B1, 1, 1); PG8_STAGE(PG8_SB(1, 0), b3, voffB);
            PG8_BAR; PG8_WAIT_L(0); PG8_MMA(0, 1, At, B1); PG8_BAR;
            PG8_LDA(At, 1, 1); PG8_STAGE(PG8_SA(1, 0), a3, voffA);
            PG8_BAR; PG8_WAIT_L(0); PG8_MMA(1, 0, At, B0); PG8_BAR; PG8_SCHED;
            PG8_STAGE(PG8_SB(1, 1), b3 + hstepB, voffB);
            PG8_WAIT_V(6); PG8_BAR; PG8_MMA(1, 1, At, B1); PG8_BAR;
            }
        }
        if constexpr (ALIGN_EPI) { if (wr == 0) PG8_BAR; }
        if constexpr (!Epi::AFTER_DRAIN) { int fr_ = fr, fq_ = fq; asm volatile("" : "+v"(fr_), "+v"(fq_));   E(acc, cur, wr, wc, fr_, fq_); S.done(cur); }
        if (!has_next) break;
#pragma unroll
        for (int a = 0; a < 2; ++a)
#pragma unroll
            for (int b = 0; b < 2; ++b)
#pragma unroll
                for (int m = 0; m < 4; ++m)
#pragma unroll
                    for (int n = 0; n < 2; ++n) acc[a][b][m][n] = (f32x4){0.f, 0.f, 0.f, 0.f};
        cur = nxt; cA = nA; cB = nB; ++ui;
        if constexpr (ALIGN_EPI) { if (wr == 1) PG8_BAR; }
    }
    PG8_WAIT_V(0);
    if constexpr (!ALIGN_EPI) { if (wr == 0) PG8_BAR; }
    PG8_BAR;
    if constexpr (Epi::AFTER_DRAIN) { E.fused(acc, cur, wr, wc, fr, fq, lds, wid, lane); S.done(cur); }
#undef PG8_SA
#undef PG8_SB
#undef PG8_STAGE
#undef PG8_LDA
#undef PG8_LDB
#undef PG8_MMA
#undef PG8_WAIT_V
#undef PG8_WAIT_L
#undef PG8_BAR
#undef PG8_SCHED
}
}
#define LAS __attribute__((address_space(3)))
typedef unsigned short bf16;
typedef unsigned v4u __attribute__((ext_vector_type(4)));
typedef unsigned v2u __attribute__((ext_vector_type(2)));
typedef float f32x4 __attribute__((ext_vector_type(4)));
typedef float f32x16 __attribute__((ext_vector_type(16)));
typedef short bf16x8 __attribute__((ext_vector_type(8)));
typedef short s16x4 __attribute__((ext_vector_type(4)));
constexpr int NB = 4, SEQ = 8192, DM = 1024, T = NB * SEQ, NIN = 5120, NH = 8;
constexpr size_t MiB = 1u << 20;
constexpr size_t WS_BAR = 0, BAR_ZERO_BYTES = 16384;
constexpr size_t WS_SSP = 1 * MiB;
constexpr size_t WS_W = 4 * MiB, W_LAYER = 14 * MiB;
constexpr size_t WS_XG = 32 * MiB;
constexpr size_t WS_VP = 96 * MiB, WS_ZP = 128 * MiB, WS_Q = 160 * MiB, WS_K = 192 * MiB, WS_V = 224 * MiB, WS_ZA = 256 * MiB;
constexpr size_t WS_G = 288 * MiB;
constexpr size_t WS_Y = 416 * MiB;
constexpr size_t WS_MG = WS_Q;
constexpr size_t WS_END = 480 * MiB;
constexpr int LDS_BYTES = 147456;
constexpr int LDS_MISC = 135168;
constexpr int NWAVES = 8, NTHREADS = 512;
constexpr int REP_P0 = 1, REP_P1 = 1, REP_P2 = 1, REP_P3A = 1, REP_SYNC = 1, REP_P3B = 1, REP_FIN = 1;

__device__ __forceinline__ unsigned f2bf(float f) { unsigned u = __builtin_bit_cast(unsigned, f); return (u + 0x7fffu + ((u >> 16) & 1u)) >> 16; }
__device__ __forceinline__ unsigned pk2(float lo, float hi) { return f2bf(lo) | (f2bf(hi) << 16); }
typedef float f32x2_t __attribute__((ext_vector_type(2))); typedef __bf16 bf16x2_t __attribute__((ext_vector_type(2)));
__device__ __forceinline__ unsigned cvtpk(float lo, float hi) { f32x2_t v = {lo, hi}; bf16x2_t b = __builtin_convertvector(v, bf16x2_t); return __builtin_bit_cast(unsigned, b); }
__device__ __forceinline__ float bflo(unsigned u) { return __uint_as_float(u << 16); }
__device__ __forceinline__ float bfhi(unsigned u) { return __uint_as_float(u & 0xffff0000u); }
__device__ __forceinline__ float wave_sum(float v) {
#pragma unroll
    for (int o = 1; o < 64; o <<= 1) v += __shfl_xor(v, o);
    return v;
}
#define LDS_WAIT() asm volatile("s_waitcnt lgkmcnt(0)" ::: "memory")

__device__ __forceinline__ void tr_item(const float* W, int ldw, bf16* WT, int ldt, int k0, int n0, int trow0, int tcol0, LAS float* scr, int lane) {
#pragma unroll 8
    for (int i = 0; i < 32; ++i) { const int kk = 2 * i + (lane >> 5); scr[kk * 33 + (lane & 31)] = W[(size_t)(k0 + kk) * ldw + n0 + (lane & 31)]; }
    LDS_WAIT();
    const int c = lane & 7;
#pragma unroll
    for (int j = 0; j < 4; ++j) { const int n = (lane >> 3) + 8 * j; const LAS float* s = scr + (8 * c) * 33 + n;
        v4u o; o.x = pk2(s[0 * 33], s[1 * 33]); o.y = pk2(s[2 * 33], s[3 * 33]); o.z = pk2(s[4 * 33], s[5 * 33]); o.w = pk2(s[6 * 33], s[7 * 33]);
        *(v4u*)(WT + (size_t)(trow0 + n) * ldt + tcol0 + 8 * c) = o; }
    LDS_WAIT();
}

#define RLX_AGENT __ATOMIC_RELAXED, __HIP_MEMORY_SCOPE_AGENT
#define XB_TMO      128
#define XB_XCNT(j)  (256  + 64 * (j))
#define XB_XSUB(j)  (1280 + 64 * (j))
#define XB_XGEN(j)  (2304 + 64 * (j))
#define XB_TOP      3328
#define XB_TOPGEN   3392
#define XCD_BAR_WORDS 3456
#define XB_SPIN_CAP (1u << 18)

__device__ __forceinline__ unsigned xb_ld(unsigned* p)              { return __hip_atomic_load(p, __ATOMIC_RELAXED, __HIP_MEMORY_SCOPE_AGENT); }
__device__ __forceinline__ unsigned xb_add(unsigned* p, unsigned v) { return __hip_atomic_fetch_add(p, v, __ATOMIC_RELAXED, __HIP_MEMORY_SCOPE_AGENT); }
__device__ __forceinline__ unsigned xb_xcc_id() { return (unsigned)__builtin_amdgcn_s_getreg((3 << 11) | 20) & 0xFu; }
#define XB_SPIN(cond, bar) do { unsigned _sp = 0; while (cond) { __builtin_amdgcn_s_sleep(1); \
    if ((++_sp & 255u) == 0u) { if (xb_ld(&(bar)[XB_TMO])) break; if (_sp > XB_SPIN_CAP) { atomicAdd(&(bar)[XB_TMO], 1u); break; } } } } while (0)

struct XcdBarrier {
    unsigned* bar; unsigned x;
    volatile LAS unsigned* st;
};

__device__ __forceinline__ XcdBarrier xcd_barrier_post(unsigned* bar, volatile LAS unsigned* st) {
    XcdBarrier b; b.bar = bar; b.x = xb_xcc_id(); b.st = st;
    if (threadIdx.x == 0) (void)xb_add(&bar[XB_XCNT(b.x)], 1u);
    return b;
}
__device__ __forceinline__ void xcd_barrier_complete(unsigned* bar, unsigned x, unsigned& nloc, unsigned& nx) {
    const unsigned G = gridDim.x * gridDim.y * gridDim.z;
    unsigned sum, cnt, mine, sp = 0u;
    for (;;) {
        sum = 0u; cnt = 0u; mine = 0u;
#pragma unroll
        for (unsigned j = 0; j < 16; ++j) { const unsigned c = xb_ld(&bar[XB_XCNT(j)]); sum += c; cnt += (c > 0u) ? 1u : 0u; mine = (j == x) ? c : mine; }
        if (sum == G) break;
        __builtin_amdgcn_s_sleep(1);
        if ((++sp & 255u) == 0u) { if (xb_ld(&bar[XB_TMO])) break; if (sp > XB_SPIN_CAP) { atomicAdd(&bar[XB_TMO], 1u); break; } }
    }
    nloc = mine > 0u ? mine : 1u; nx = cnt > 0u ? cnt : 1u;
}

__device__ __forceinline__ void xcd_barrier(const XcdBarrier& b) {
    asm volatile("s_waitcnt vmcnt(0)" ::: "memory");
    __syncthreads();
    if (threadIdx.x == 0) {
        unsigned* bar = b.bar;
        __builtin_amdgcn_s_waitcnt(0);
        unsigned nloc = b.st[0], nx = b.st[1];
        if (nloc == 0u) { xcd_barrier_complete(bar, b.x, nloc, nx); b.st[0] = nloc; b.st[1] = nx; }
        const unsigned old = xb_add(&bar[XB_XSUB(b.x)], 1u);
        const unsigned gen = old / nloc;
        if (old + 1u == (gen + 1u) * nloc) {
            __builtin_amdgcn_fence(__ATOMIC_RELEASE, "agent");
            asm volatile("s_waitcnt vmcnt(0)" ::: "memory");
            const unsigned og = xb_add(&bar[XB_TOP], 1u);
            const unsigned tg = og / nx;
            if (og + 1u == (tg + 1u) * nx) xb_add(&bar[XB_TOPGEN], 1u);
            else XB_SPIN(xb_ld(&bar[XB_TOPGEN]) == tg, bar);
            __builtin_amdgcn_fence(__ATOMIC_ACQUIRE, "agent");
            xb_add(&bar[XB_XGEN(b.x)], 1u);
            asm volatile("s_waitcnt vmcnt(0)" ::: "memory");
        } else {
            XB_SPIN(xb_ld(&bar[XB_XGEN(b.x)]) == gen, bar);
            __builtin_amdgcn_fence(__ATOMIC_ACQUIRE, "agent");
            asm volatile("s_waitcnt vmcnt(0)" ::: "memory");
        }
    }
    __syncthreads();
}
constexpr int VPITCH = 144;
constexpr float SB_EXIT = 1.17549435e-38f;
__device__ __forceinline__ int crow(int r, int hi) { return (r & 3) + 8 * (r >> 2) + 4 * hi; }
__device__ __forceinline__ s16x4 vtr(const LAS unsigned char* p) { typedef short v4i16_t __attribute__((ext_vector_type(4)));
    return __builtin_bit_cast(s16x4, __builtin_amdgcn_ds_read_tr16_b64_v4i16((LAS v4i16_t*)p)); }
__device__ __forceinline__ void attn_unit(const bf16* __restrict__ Q, const bf16* __restrict__ K, const bf16* __restrict__ V, const bf16* __restrict__ ZA, bf16* __restrict__ Y,
                                          int b, int h, int qt, LAS unsigned char* vl, int lane) {
    const int j = lane & 31, hi = lane >> 5;
    const size_t row0 = (size_t)b * SEQ + (size_t)qt * 32;
    const bf16* qp = Q + (row0 + j) * 512 + h * 64 + 8 * hi;
    bf16x8 qf[4];
#pragma unroll
    for (int s = 0; s < 4; ++s) qf[s] = *(const bf16x8*)(qp + 16 * s);
    f32x16 o0, o1;
#pragma unroll
    for (int r = 0; r < 16; ++r) { o0[r] = 0.f; o1[r] = 0.f; }
    float pc = 1.0f;
    const int blk = (lane >> 4) & 1, q4 = (lane & 15) >> 2, p4 = lane & 3;
    const unsigned trb = (unsigned)((4 * hi + q4) * VPITCH + (16 * blk + 4 * p4) * 2);
    const unsigned vwb = (unsigned)((lane >> 3) * VPITCH + (lane & 7) * 16);
    const bf16* kp = K + ((size_t)b * SEQ + (size_t)qt * 32 + j) * 512 + h * 64 + 8 * hi;
    const bf16* vp = V + ((size_t)b * SEQ + (size_t)qt * 32 + (lane >> 3)) * 512 + h * 64 + (lane & 7) * 8;
    bf16x8 kf[4], kfn[4]; v4u vv[4], vvn[4];
#pragma unroll
    for (int s = 0; s < 4; ++s) kf[s] = *(const bf16x8*)(kp + 16 * s);
#pragma unroll
    for (int i = 0; i < 4; ++i) vv[i] = *(const v4u*)(vp + (size_t)i * 8 * 512);
    for (int kt = qt; kt >= 0; --kt) {
        if (kt > 0) {
            kp -= 32 * 512; vp -= 32 * 512;
#pragma unroll
            for (int s = 0; s < 4; ++s) kfn[s] = *(const bf16x8*)(kp + 16 * s);
#pragma unroll
            for (int i = 0; i < 4; ++i) vvn[i] = *(const v4u*)(vp + (size_t)i * 8 * 512);
        }
        f32x16 sc;
#pragma unroll
        for (int r = 0; r < 16; ++r) sc[r] = 0.f;
#pragma unroll
        for (int s = 0; s < 4; ++s) sc = __builtin_amdgcn_mfma_f32_32x32x16_bf16(kf[s], qf[s], sc, 0, 0, 0);
        asm volatile("" ::: "memory");
#pragma unroll
        for (int i = 0; i < 4; ++i) *(LAS v4u*)(vl + vwb + i * 8 * VPITCH) = vv[i];
        asm volatile("" ::: "memory");
        const bool diag = (kt == qt);
        float be[16], om[16];
#pragma unroll
        for (int r = 0; r < 16; ++r) { const float e = __builtin_amdgcn_exp2f(-__builtin_fmaxf(sc[r], -126.0f)); const float bb = __builtin_amdgcn_rcpf(1.0f + e);
            be[r] = bb; om[r] = e * bb; }
        if (diag) {
#pragma unroll
            for (int r = 0; r < 16; ++r) if (crow(r, hi) >= j) { be[r] = 0.f; om[r] = 1.0f; } }
        float Rp[4], Tt[4];
#pragma unroll
        for (int a = 0; a < 4; ++a) { const float R = (om[4 * a] * om[4 * a + 1]) * (om[4 * a + 2] * om[4 * a + 3]); Rp[a] = __shfl_xor(R, 32); Tt[a] = R * Rp[a]; }
        float suf = pc; float w[16];
#pragma unroll
        for (int a = 3; a >= 0; --a) { float c = (hi == 0) ? suf * Rp[a] : suf;
            w[4 * a + 3] = be[4 * a + 3] * c; c *= om[4 * a + 3];
            w[4 * a + 2] = be[4 * a + 2] * c; c *= om[4 * a + 2];
            w[4 * a + 1] = be[4 * a + 1] * c; c *= om[4 * a + 1];
            w[4 * a] = be[4 * a] * c;
            suf *= Tt[a]; }
        pc = suf;
        bf16x8 pf[2];
#pragma unroll
        for (int s = 0; s < 2; ++s) { v4u p; p.x = cvtpk(w[8 * s], w[8 * s + 1]); p.y = cvtpk(w[8 * s + 2], w[8 * s + 3]); p.z = cvtpk(w[8 * s + 4], w[8 * s + 5]); p.w = cvtpk(w[8 * s + 6], w[8 * s + 7]);
            pf[s] = __builtin_bit_cast(bf16x8, p); }
#pragma unroll
        for (int s = 0; s < 2; ++s) {
            { const s16x4 lo = vtr(vl + trb + (16 * s) * VPITCH), hh = vtr(vl + trb + (16 * s + 8) * VPITCH);
              const bf16x8 vf = (bf16x8){lo[0], lo[1], lo[2], lo[3], hh[0], hh[1], hh[2], hh[3]};
              o0 = __builtin_amdgcn_mfma_f32_32x32x16_bf16(vf, pf[s], o0, 0, 0, 0); }
            { const s16x4 lo = vtr(vl + trb + (16 * s) * VPITCH + 64), hh = vtr(vl + trb + (16 * s + 8) * VPITCH + 64);
              const bf16x8 vf = (bf16x8){lo[0], lo[1], lo[2], lo[3], hh[0], hh[1], hh[2], hh[3]};
              o1 = __builtin_amdgcn_mfma_f32_32x32x16_bf16(vf, pf[s], o1, 0, 0, 0); }
        }
        asm volatile("" ::: "memory");
        if (__ballot(pc >= SB_EXIT) == 0ull) break;
#pragma unroll
        for (int s = 0; s < 4; ++s) { kf[s] = kfn[s]; vv[s] = vvn[s]; }
    }
    const size_t zrow = (row0 + j) * 512 + h * 64, yrow = (row0 + j) * 1024 + 512 + h * 64;
#pragma unroll
    for (int a = 0; a < 4; ++a) { const int d0 = 8 * a + 4 * hi;
        { const v2u zz = *(const v2u*)(ZA + zrow + d0); v2u o; o.x = cvtpk(o0[4 * a] * bflo(zz.x), o0[4 * a + 1] * bfhi(zz.x)); o.y = cvtpk(o0[4 * a + 2] * bflo(zz.y), o0[4 * a + 3] * bfhi(zz.y));
          *(v2u*)(Y + yrow + d0) = o; }
        { const v2u zz = *(const v2u*)(ZA + zrow + 32 + d0); v2u o; o.x = cvtpk(o1[4 * a] * bflo(zz.x), o1[4 * a + 1] * bfhi(zz.x)); o.y = cvtpk(o1[4 * a + 2] * bflo(zz.y), o1[4 * a + 3] * bfhi(zz.y));
          *(v2u*)(Y + yrow + 32 + d0) = o; } }
}

__device__ __forceinline__ void unpack8(const v4u q, float (&f)[8]) { f[0] = bflo(q.x); f[1] = bfhi(q.x); f[2] = bflo(q.y); f[3] = bfhi(q.y); f[4] = bflo(q.z); f[5] = bfhi(q.z); f[6] = bflo(q.w); f[7] = bfhi(q.w); }
template <int W> __device__ __forceinline__ void pool_wave_task(const bf16* __restrict__ VP, const bf16* __restrict__ ZP, bf16* __restrict__ Y, int g, int tblk, int lane) {
    const int t0 = tblk * 32 + (lane >> 4) * 8, pos0 = t0 & (SEQ - 1), ch = g * 128 + (lane & 15) * 8;
    const bf16* vp = VP + (size_t)t0 * 512 + ch; const bf16* zp = ZP + (size_t)t0 * 512 + ch; bf16* yp = Y + (size_t)t0 * 1024 + ch;
    v4u hv[W + 7], zv[8];
#pragma unroll
    for (int i = 0; i < W + 7; ++i) { const int off = i - (W - 1); hv[i] = (pos0 + off >= 0) ? *(const v4u*)(vp + (ptrdiff_t)off * 512) : (v4u){0u, 0u, 0u, 0u}; }
#pragma unroll
    for (int t = 0; t < 8; ++t) zv[t] = *(const v4u*)(zp + (size_t)t * 512);
    float s[8];
#pragma unroll
    for (int e = 0; e < 8; ++e) s[e] = 0.f;
#pragma unroll
    for (int i = 0; i < W - 1; ++i) { float f[8]; unpack8(hv[i], f);
#pragma unroll
        for (int e = 0; e < 8; ++e) s[e] += f[e]; }
#pragma unroll
    for (int t = 0; t < 8; ++t) { float v[8], z[8], y[8]; unpack8(hv[W - 1 + t], v); unpack8(zv[t], z);
        const int cnt = (pos0 + t + 1 < W) ? pos0 + t + 1 : W; const float inv = __builtin_amdgcn_rcpf((float)cnt);
#pragma unroll
        for (int e = 0; e < 8; ++e) { s[e] += v[e]; y[e] = (s[e] * inv - v[e]) * z[e]; }
        v4u o; o.x = cvtpk(y[0], y[1]); o.y = cvtpk(y[2], y[3]); o.z = cvtpk(y[4], y[5]); o.w = cvtpk(y[6], y[7]);
        *(v4u*)(yp + (size_t)t * 1024) = o;
        float f[8]; unpack8(hv[t], f);
#pragma unroll
        for (int e = 0; e < 8; ++e) s[e] -= f[e]; }
}

struct Args { const float* in[10]; float* out; unsigned char* ws; };
__global__ void __launch_bounds__(NTHREADS, 2) fwd_megakernel(Args args) {
    extern __shared__ __attribute__((aligned(16))) unsigned char lds_raw[];
    LAS unsigned char* lds = (LAS unsigned char*)lds_raw;
    const int tid = threadIdx.x, lane = tid & 63, wave = __builtin_amdgcn_readfirstlane(tid >> 6);
    const int G = gridDim.x, bx = blockIdx.x, vcu = (G % 8 == 0) ? (bx % 8) * (G / 8) + bx / 8 : bx;
    const int gw = vcu * NWAVES + wave, NGW = G * NWAVES;
    volatile LAS unsigned* MISC = (volatile LAS unsigned*)(lds + LDS_MISC);
    if (tid < 4) MISC[tid] = 0u;
    __syncthreads();
    const XcdBarrier bar = xcd_barrier_post((unsigned*)(args.ws + WS_BAR), MISC);
    const float* x = args.in[0]; const float* norm_g = args.in[1]; const float* w_in = args.in[2]; const float* b_gate = args.in[3]; const float* pool_w = args.in[4];
    const float* pool_scale = args.in[5]; const float* w_pool_up = args.in[6]; const float* w_attn_up = args.in[7]; const float* w_out = args.in[8]; const float* final_g = args.in[9];
    float* out = args.out; unsigned char* ws = args.ws;
    float* SSP = (float*)(ws + WS_SSP);
    bf16* XG = (bf16*)(ws + WS_XG); bf16* VP = (bf16*)(ws + WS_VP); bf16* ZP = (bf16*)(ws + WS_ZP); bf16* Qb = (bf16*)(ws + WS_Q); bf16* Kb = (bf16*)(ws + WS_K);
    bf16* Vb = (bf16*)(ws + WS_V); bf16* ZA = (bf16*)(ws + WS_ZA); bf16* Gt = (bf16*)(ws + WS_G); bf16* Yb = (bf16*)(ws + WS_Y); bf16* MG = (bf16*)(ws + WS_MG);

#pragma nounroll
    for (int rep = 0; rep < REP_P0; ++rep) {
        LAS float* PW = (LAS float*)lds; LAS float* WI = (LAS float*)(lds + 65536);
        for (int it = vcu; it < 256; it += G) {
            const int l = it >> 7, g = (it >> 5) & 3, k0 = (it & 31) * 32;
            const float* pw = pool_w + ((size_t)l * 4 + g) * 16384; const float* wi = w_in + (size_t)l * DM * NIN + (size_t)k0 * NIN + g * 128;
            __syncthreads();
#pragma unroll 4
            for (int i = 0; i < 32; ++i) PW[tid + 512 * i] = pw[tid + 512 * i];
#pragma unroll
            for (int i = 0; i < 8; ++i) { const int idx = tid + 512 * i; WI[idx] = wi[(size_t)(idx >> 7) * NIN + (idx & 127)]; }
            __syncthreads();
            const int d = tid & 127, kq = tid >> 7; float acc[8];
#pragma unroll
            for (int e = 0; e < 8; ++e) acc[e] = 0.f;
            for (int c = 0; c < 128; ++c) { const float p = PW[c * 128 + d];
#pragma unroll
                for (int e = 0; e < 8; ++e) acc[e] += WI[(kq * 8 + e) * 128 + c] * p; }
            const float sc = pool_scale[l * 512 + g * 128 + d];
            v4u o; o.x = pk2(acc[0] * sc, acc[1] * sc); o.y = pk2(acc[2] * sc, acc[3] * sc); o.z = pk2(acc[4] * sc, acc[5] * sc); o.w = pk2(acc[6] * sc, acc[7] * sc);
            bf16* wt = (bf16*)(ws + WS_W + (size_t)l * W_LAYER);
            *(v4u*)(wt + (size_t)(g * 128 + d) * 1024 + k0 + kq * 8) = o;
        }
        __syncthreads();
        LAS float* scr = (LAS float*)(lds + wave * 16384);
        for (int it = gw; it < 6656; it += NGW) {
            const int l = it / 3328; int r = it % 3328;
            bf16* win_t = (bf16*)(ws + WS_W + (size_t)l * W_LAYER); bf16* wpa_t = win_t + (size_t)NIN * 1024; bf16* wout_t = wpa_t + (size_t)1024 * 1024;
            if (r < 2304) { const int kb = r / 144, nb = r % 144; tr_item(w_in + (size_t)l * DM * NIN, NIN, win_t, 1024, kb * 64, 512 + nb * 32, 512 + nb * 32, kb * 64, scr, lane); continue; } r -= 2304;
            if (r < 256) { const int kb = r / 32, nb = r % 32; tr_item(w_pool_up + (size_t)l * 512 * 1024, 1024, wpa_t, 1024, kb * 64, nb * 32, nb * 32, kb * 64, scr, lane); continue; } r -= 256;
            if (r < 256) { const int kb = r / 32, nb = r % 32; tr_item(w_attn_up + (size_t)l * 512 * 1024, 1024, wpa_t, 1024, kb * 64, nb * 32, nb * 32, 512 + kb * 64, scr, lane); continue; } r -= 256;
            { const int kb = r / 32, nb = r % 32; tr_item(w_out + (size_t)l * 1024 * 1024, 1024, wout_t, 1024, kb * 64, nb * 32, nb * 32, kb * 64, scr, lane); }
        }
        for (int m = gw; m < T; m += NGW) {
            const f32x4* xr = (const f32x4*)(x + (size_t)m * DM) + lane; const f32x4* gr = (const f32x4*)norm_g + lane;
            f32x4 v[4]; float s = 0.f;
#pragma unroll
            for (int jx = 0; jx < 4; ++jx) { v[jx] = xr[64 * jx]; s += (v[jx][0] * v[jx][0] + v[jx][1] * v[jx][1]) + (v[jx][2] * v[jx][2] + v[jx][3] * v[jx][3]); }
            s = wave_sum(s);
            v2u* o8 = (v2u*)(XG + (size_t)m * DM) + lane;
#pragma unroll
            for (int jx = 0; jx < 4; ++jx) { const f32x4 gg = gr[64 * jx]; v2u o; o.x = pk2(v[jx][0] * gg[0], v[jx][1] * gg[1]); o.y = pk2(v[jx][2] * gg[2], v[jx][3] * gg[3]); o8[64 * jx] = o; }
            if (lane < 16) SSP[(size_t)m * 16 + lane] = (lane == 0) ? s : 0.f;
        }
    }
    xcd_barrier(bar);

    for (int l = 0; l < 2; ++l) {
        const bf16* win_t = (const bf16*)(ws + WS_W + (size_t)l * W_LAYER); const bf16* wpa_t = win_t + (size_t)NIN * 1024; const bf16* wout_t = wpa_t + (size_t)1024 * 1024;
#pragma nounroll
        for (int rep = 0; rep < REP_P1; ++rep) {   pg8::Gemm g{XG, win_t, T, NIN, DM, DM, DM}; pg8::StaticOrder S; S.init(T, NIN, G, bx);
            pg8::EpiProj E{VP, ZP, Qb, Kb, Vb, ZA, Gt, SSP, b_gate + l * 2048};
            pg8::gemm_phase<pg8::EpiProj, pg8::StaticOrder, true, true>(lds, g, S, E); }
#pragma nounroll
        for (int rep = 0; rep < REP_SYNC; ++rep) xcd_barrier(bar);
#pragma nounroll
        for (int rep = 0; rep < REP_P2; ++rep) {   LAS unsigned char* vl = lds + wave * 8192;
            int ln = lane; asm volatile("" : "+v"(ln));
            for (int u = gw; u < NB * NH * (SEQ / 32); u += NGW) { const int qt = u & 255, bh = u >> 8; attn_unit(Qb, Kb, Vb, ZA, Yb, bh >> 3, bh & 7, qt, vl, ln); }
            for (int wt = gw; wt < (T / 32) * 4; wt += NGW) { const int g = wt & 3, tblk = wt >> 2;
                if (g == 0) pool_wave_task<2>(VP, ZP, Yb, 0, tblk, ln); else if (g == 1) pool_wave_task<4>(VP, ZP, Yb, 1, tblk, ln);
                else if (g == 2) pool_wave_task<8>(VP, ZP, Yb, 2, tblk, ln); else pool_wave_task<16>(VP, ZP, Yb, 3, tblk, ln); } }
        xcd_barrier(bar);
#pragma nounroll
        for (int rep = 0; rep < REP_P3A; ++rep) {   pg8::StaticOrder S; S.init(T, DM, G, bx);
            { pg8::Gemm g{Yb, wpa_t, T, DM, 512, 1024, 1024}; pg8::EpiMerge<0> E{MG, Gt}; pg8::gemm_phase<pg8::EpiMerge<0>, pg8::StaticOrder, true, true>(lds, g, S, E); }
            { pg8::Gemm g{Yb + 512, wpa_t + 512, T, DM, 512, 1024, 1024}; pg8::EpiMerge<1> E{MG, Gt}; pg8::gemm_phase<pg8::EpiMerge<1>, pg8::StaticOrder, true, true>(lds, g, S, E); } }
        xcd_barrier(bar);
#pragma nounroll
        for (int rep = 0; rep < (l == 0 ? REP_P3B : 1); ++rep) {   pg8::Gemm g{MG, wout_t, T, DM, DM, DM, DM}; pg8::StaticOrder S; S.init(T, DM, G, bx);
            pg8::EpiOut E{l == 0 ? x : (const float*)out, out, XG, norm_g + 1024, SSP, l == 0 ? 1 : 0};
            pg8::gemm_phase<pg8::EpiOut, pg8::StaticOrder, true, true>(lds, g, S, E); }
        xcd_barrier(bar);
    }
#pragma nounroll
    for (int rep = 0; rep < REP_FIN; ++rep)
    for (int m = gw; m < T; m += NGW) {
        float ss = SSP[(size_t)m * 16 + (lane & 15)];
        ss += __shfl_xor(ss, 1); ss += __shfl_xor(ss, 2); ss += __shfl_xor(ss, 4); ss += __shfl_xor(ss, 8);
        const float rstd = __builtin_amdgcn_rsqf(ss * (1.0f / 1024.0f) + 1e-6f);
        f32x4* xr = (f32x4*)(out + (size_t)m * DM) + lane; const f32x4* gr = (const f32x4*)final_g + lane;
        f32x4* xw = (rep == REP_FIN - 1) ? xr : (f32x4*)((float*)(ws + WS_G) + (size_t)m * DM) + lane;
#pragma unroll
        for (int jx = 0; jx < 4; ++jx) { const f32x4 v = xr[64 * jx]; xw[64 * jx] = v * rstd * gr[64 * jx]; }
    }
}

extern "C" void kernel_launch(void* const* d_in, const int* in_sizes, int n_in, void* d_out, int out_size, void* d_ws, size_t ws_size, hipStream_t stream) {
    static int grid = 0;
    if (grid == 0) {
        if (n_in != 10 || in_sizes[0] != T * DM || out_size != T * DM || ws_size < WS_END) { fprintf(stderr, "kernel_launch: unexpected shapes / workspace (ws %zu, need %zu)\n", ws_size, (size_t)WS_END); grid = -1; return; }
        int dev = 0, cus = 0, per_cu = 0;
        hipGetDevice(&dev); hipDeviceGetAttribute(&cus, hipDeviceAttributeMultiprocessorCount, dev);
        hipFuncSetAttribute((const void*)fwd_megakernel, hipFuncAttributeMaxDynamicSharedMemorySize, LDS_BYTES);
        hipOccupancyMaxActiveBlocksPerMultiprocessor(&per_cu, (const void*)fwd_megakernel, NTHREADS, LDS_BYTES);
        if (per_cu < 1) { fprintf(stderr, "kernel_launch: occupancy query says %d blocks per CU\n", per_cu); per_cu = 1; }
        grid = cus * per_cu;
    }
    if (grid < 0) return;
    if (hipMemsetAsync((char*)d_ws + WS_BAR, 0, BAR_ZERO_BYTES, stream) != hipSuccess) { fprintf(stderr, "kernel_launch: memset of the barrier words failed\n"); return; }
    Args a{};
    for (int i = 0; i < 10; ++i) a.in[i] = (const float*)d_in[i];
    a.out = (float*)d_out; a.ws = (unsigned char*)d_ws;
    void* kargs[] = {&a};
    hipError_t e = hipLaunchCooperativeKernel((const void*)fwd_megakernel, dim3(grid), dim3(NTHREADS), kargs, LDS_BYTES, stream);
    if (e != hipSuccess) fprintf(stderr, "cooperative launch failed: %s (grid %d)\n", hipGetErrorString(e), grid);
}
```

```cpp
#include <hip/hip_runtime.h>
#include <hip/hip_cooperative_groups.h>
#include <cstdio>
#include <cstdint>
namespace cg = cooperative_groups;
namespace pg8 {
#define PG8_LAS __attribute__((address_space(3)))
typedef unsigned short bf16_t;
typedef short bf16x8 __attribute__((ext_vector_type(8)));
typedef float f32x4 __attribute__((ext_vector_type(4)));
typedef unsigned u32x4 __attribute__((ext_vector_type(4)));
constexpr int BM = 256, BK = 64, HALF = 128, HTB = HALF * BK * 2  , STAGE_BYTES = 8 * HTB, NXCD = 8, WGM = 8;

__host__ __device__ __forceinline__ int lds_byte(int r, int c) { const int st = (r >> 4) * 2 + (c >> 5), rr = r & 15, cc = c & 31, ob = rr * 64 + cc * 2; return st * 1024 + (ob ^ (((ob >> 9) & 1) << 5)); }
__host__ __device__ __forceinline__ void stage_rc(int b, int& R, int& C) { const int st = b / 1024, sb = b % 1024, swz = sb ^ (((sb >> 9) & 1) << 5); R = (st >> 1) * 16 + swz / 64; C = (st & 1) * 32 + (swz % 64) / 2; }
__host__ __device__ __forceinline__ int perm32(int rho) { const int n = rho >> 4, i = rho & 15; return 8 * (i >> 2) + 4 * n + (i & 3); }

struct Unit { int pm, pn; };
struct Gemm { const bf16_t* A; const bf16_t* Bt; int M, N, K, lda, ldb; };

struct StaticOrder {
    int nM, nN, nwg, G, c;
    __host__ __device__ void init(int M, int N, int G_, int c_) { nM = M / BM; nN = N / BM; nwg = nM * nN; G = G_; c = c_; }
    __host__ __device__ bool next(int i, Unit& u) const {
        const long L = (long)i * G + c; if (L >= nwg) return false;
        int wgid = (int)L; { const int q = nwg / NXCD, r = nwg % NXCD, xcd = wgid % NXCD, off = wgid / NXCD; wgid = (xcd < r ? xcd * (q + 1) : r * (q + 1) + (xcd - r) * q) + off; }
        const int nig = WGM * nN, gid = wgid / nig, fm = gid * WGM, gsz = (nM - fm) < WGM ? (nM - fm) : WGM;
        u.pm = fm + ((wgid % nig) % gsz); u.pn = (wgid % nig) / gsz; return true;
    }
    __device__ __forceinline__ void a_ready(const Unit&) const {}
    __device__ __forceinline__ void done(const Unit&) const {}
};

__device__ __forceinline__ unsigned cvt_pk_bf16(float lo, float hi) { unsigned r; asm volatile("v_cvt_pk_bf16_f32 %0, %1, %2" : "=v"(r) : "v"(lo), "v"(hi)); return r; }
typedef float f32x2 __attribute__((ext_vector_type(2)));
__device__ __forceinline__ float bf_lo(unsigned u) { return __uint_as_float(u << 16); }
__device__ __forceinline__ float bf_hi(unsigned u) { return __uint_as_float(u & 0xffff0000u); }
__device__ __forceinline__ float sigmoid_f(float v) { return __builtin_amdgcn_rcpf(1.0f + __builtin_amdgcn_exp2f(-1.4426950408889634f * v)); }
constexpr float RMS_EPS_F = 1e-6f;
constexpr float QSCALE = 0.125f * 1.4426950408889634f;

struct EpiProj {
    static constexpr bool PERM = true, AFTER_DRAIN = false, HAS_MID = false;
    bf16_t *VP, *ZP, *Q, *K, *V, *ZA, *G; const float* ssp; const float* bgate;
    __device__ __forceinline__ void operator()(const f32x4 (&acc)[2][2][4][2], const Unit& u, int wr, int wc, int fr, int fq) const {
        const int pn = u.pn; bf16_t* base; int ld, mode, colt; float sc = 1.f;
        if (pn < 12) { const int seg = pn >> 1; colt = (pn & 1) * 256; ld = 512;
            base = seg == 0 ? VP : seg == 1 ? ZP : seg == 2 ? Q : seg == 3 ? K : seg == 4 ? V : ZA;
            mode = (seg == 1 || seg == 5) ? 1 : 0; if (seg == 2) sc = QSCALE; }
        else { base = G; colt = (pn - 12) * 256; ld = 2048; mode = 2; }
        const int row0 = u.pm * BM + wr * 64 + fr, col0 = colt + wc * 32 + 8 * fq;
        f32x4 bv[2][2];
#pragma unroll
        for (int bj = 0; bj < 2; ++bj)
#pragma unroll
            for (int n = 0; n < 2; ++n) bv[bj][n] = (mode == 2) ? *(const f32x4*)(bgate + col0 + bj * HALF + 4 * n) : (f32x4){0.f, 0.f, 0.f, 0.f};
#pragma unroll
        for (int ai = 0; ai < 2; ++ai)
#pragma unroll
            for (int m = 0; m < 4; ++m) { const int row = row0 + ai * HALF + m * 16;
                const f32x4 st = *((const f32x4*)(ssp + (size_t)row * 16) + fq);
                float ss = (st[0] + st[1]) + (st[2] + st[3]); ss += __shfl_xor(ss, 16); ss += __shfl_xor(ss, 32);
                const float rstd = __builtin_amdgcn_rsqf(ss * (1.0f / 1024.0f) + RMS_EPS_F) * sc;
                bf16_t* rowp = base + (size_t)row * ld + col0;
#pragma unroll
                for (int bj = 0; bj < 2; ++bj) { f32x4 v0 = acc[ai][bj][m][0] * rstd, v1 = acc[ai][bj][m][1] * rstd;
                    if (mode == 2) { v0 = v0 + bv[bj][0]; v1 = v1 + bv[bj][1];
#pragma unroll
                        for (int e = 0; e < 4; ++e) { v0[e] = sigmoid_f(v0[e]); v1[e] = sigmoid_f(v1[e]); } }
                    else if (mode == 1) {
#pragma unroll
                        for (int e = 0; e < 4; ++e) { v0[e] = v0[e] * sigmoid_f(v0[e]); v1[e] = v1[e] * sigmoid_f(v1[e]); } }
                    u32x4 w; w.x = cvt_pk_bf16(v0[0], v0[1]); w.y = cvt_pk_bf16(v0[2], v0[3]); w.z = cvt_pk_bf16(v1[0], v1[1]); w.w = cvt_pk_bf16(v1[2], v1[3]);
                    *(u32x4*)(rowp + bj * HALF) = w; } }
    }
};
template <int PASS> struct EpiMerge {
    static constexpr bool PERM = true, AFTER_DRAIN = false, HAS_MID = false;
    bf16_t* MG; const bf16_t* G;
    __device__ __forceinline__ void operator()(const f32x4 (&acc)[2][2][4][2], const Unit& u, int wr, int wc, int fr, int fq) const {
        const int row0 = u.pm * BM + wr * 64 + fr, col0 = u.pn * BM + wc * 32 + 8 * fq;
#pragma unroll
        for (int ai = 0; ai < 2; ++ai)
#pragma unroll
            for (int m = 0; m < 4; ++m) { const int row = row0 + ai * HALF + m * 16;
#pragma unroll
                for (int bj = 0; bj < 2; ++bj) { const int col = col0 + bj * HALF;
                    const u32x4 gq = *(const u32x4*)(G + (size_t)row * 2048 + PASS * 1024 + col);
                    f32x4 v0 = acc[ai][bj][m][0], v1 = acc[ai][bj][m][1];
                    v0[0] *= bf_lo(gq.x); v0[1] *= bf_hi(gq.x); v0[2] *= bf_lo(gq.y); v0[3] *= bf_hi(gq.y);
                    v1[0] *= bf_lo(gq.z); v1[1] *= bf_hi(gq.z); v1[2] *= bf_lo(gq.w); v1[3] *= bf_hi(gq.w);
                    u32x4* mp = (u32x4*)(MG + (size_t)row * 1024 + col);
                    if (PASS == 1) { const u32x4 pq = *mp;
                        v0[0] += bf_lo(pq.x); v0[1] += bf_hi(pq.x); v0[2] += bf_lo(pq.y); v0[3] += bf_hi(pq.y);
                        v1[0] += bf_lo(pq.z); v1[1] += bf_hi(pq.z); v1[2] += bf_lo(pq.w); v1[3] += bf_hi(pq.w); }
                    u32x4 w; w.x = cvt_pk_bf16(v0[0], v0[1]); w.y = cvt_pk_bf16(v0[2], v0[3]); w.z = cvt_pk_bf16(v1[0], v1[1]); w.w = cvt_pk_bf16(v1[2], v1[3]);
                    *mp = w; } }
    }
};
struct EpiMergeMid {
    static constexpr bool PERM = true, AFTER_DRAIN = false, HAS_MID = true;
    bf16_t* MG; const bf16_t* G;
    static constexpr float GMIN = 7.8886090522101181e-31f;
    __device__ __forceinline__ void mid(f32x4 (&acc)[2][2][4][2], const Unit& u, int wr, int wc, int fr, int fq) const {
        const int row0 = u.pm * BM + wr * 64 + fr, col0 = u.pn * BM + wc * 32 + 8 * fq;
#pragma unroll
        for (int ai = 0; ai < 2; ++ai)
#pragma unroll
            for (int m = 0; m < 4; ++m) { const int row = row0 + ai * HALF + m * 16;
#pragma unroll
                for (int bj = 0; bj < 2; ++bj) { const bf16_t* gp = G + (size_t)row * 2048 + col0 + bj * HALF;
                    const u32x4 a = *(const u32x4*)gp, b = *(const u32x4*)(gp + 1024);
                    f32x4& v0 = acc[ai][bj][m][0]; f32x4& v1 = acc[ai][bj][m][1];
                    v0[0] *= bf_lo(a.x) * __builtin_amdgcn_rcpf(__builtin_fmaxf(bf_lo(b.x), GMIN)); v0[1] *= bf_hi(a.x) * __builtin_amdgcn_rcpf(__builtin_fmaxf(bf_hi(b.x), GMIN));
                    v0[2] *= bf_lo(a.y) * __builtin_amdgcn_rcpf(__builtin_fmaxf(bf_lo(b.y), GMIN)); v0[3] *= bf_hi(a.y) * __builtin_amdgcn_rcpf(__builtin_fmaxf(bf_hi(b.y), GMIN));
                    v1[0] *= bf_lo(a.z) * __builtin_amdgcn_rcpf(__builtin_fmaxf(bf_lo(b.z), GMIN)); v1[1] *= bf_hi(a.z) * __builtin_amdgcn_rcpf(__builtin_fmaxf(bf_hi(b.z), GMIN));
                    v1[2] *= bf_lo(a.w) * __builtin_amdgcn_rcpf(__builtin_fmaxf(bf_lo(b.w), GMIN)); v1[3] *= bf_hi(a.w) * __builtin_amdgcn_rcpf(__builtin_fmaxf(bf_hi(b.w), GMIN)); } }
    }
    __device__ __forceinline__ void operator()(const f32x4 (&acc)[2][2][4][2], const Unit& u, int wr, int wc, int fr, int fq) const {
        const int row0 = u.pm * BM + wr * 64 + fr, col0 = u.pn * BM + wc * 32 + 8 * fq;
#pragma unroll
        for (int ai = 0; ai < 2; ++ai)
#pragma unroll
            for (int m = 0; m < 4; ++m) { const int row = row0 + ai * HALF + m * 16;
#pragma unroll
                for (int bj = 0; bj < 2; ++bj) { const int col = col0 + bj * HALF;
                    const u32x4 b = *(const u32x4*)(G + (size_t)row * 2048 + 1024 + col);
                    const f32x4 v0 = acc[ai][bj][m][0], v1 = acc[ai][bj][m][1];
                    u32x4 w; w.x = cvt_pk_bf16(v0[0] * __builtin_fmaxf(bf_lo(b.x), GMIN), v0[1] * __builtin_fmaxf(bf_hi(b.x), GMIN)); w.y = cvt_pk_bf16(v0[2] * __builtin_fmaxf(bf_lo(b.y), GMIN), v0[3] * __builtin_fmaxf(bf_hi(b.y), GMIN));
                    w.z = cvt_pk_bf16(v1[0] * __builtin_fmaxf(bf_lo(b.z), GMIN), v1[1] * __builtin_fmaxf(bf_hi(b.z), GMIN)); w.w = cvt_pk_bf16(v1[2] * __builtin_fmaxf(bf_lo(b.w), GMIN), v1[3] * __builtin_fmaxf(bf_hi(b.w), GMIN));
                    *(u32x4*)(MG + (size_t)row * 1024 + col) = w; } }
    }
};
struct EpiOut {
    static constexpr bool PERM = false, AFTER_DRAIN = false, HAS_MID = false;
    const float* xin; float* xout; bf16_t* XG; const float* gnext; float* ssp; int write_xg;
    __device__ __forceinline__ void operator()(const f32x4 (&acc)[2][2][4][2], const Unit& u, int wr, int wc, int fr, int fq) const {
        typedef unsigned u32x2v __attribute__((ext_vector_type(2)));
        const int col0 = u.pn * BM + wc * 32 + 4 * fq;
#pragma unroll
        for (int ai = 0; ai < 2; ++ai)
#pragma unroll
            for (int m = 0; m < 4; ++m) { const int row = u.pm * BM + ai * HALF + wr * 64 + m * 16 + fr; const size_t off = (size_t)row * 1024 + col0; float ss = 0.f;
#pragma unroll
                for (int bj = 0; bj < 2; ++bj)
#pragma unroll
                    for (int n = 0; n < 2; ++n) { const int co = bj * HALF + n * 16;
                        const f32x4 v = *(const f32x4*)(xin + off + co) + acc[ai][bj][m][n];
                        *(f32x4*)(xout + off + co) = v; ss += (v[0] * v[0] + v[1] * v[1]) + (v[2] * v[2] + v[3] * v[3]);
                        if (write_xg) { const f32x4 gg = *(const f32x4*)(gnext + col0 + co); u32x2v w; w.x = cvt_pk_bf16(v[0] * gg[0], v[1] * gg[1]); w.y = cvt_pk_bf16(v[2] * gg[2], v[3] * gg[3]);
                            *(u32x2v*)(XG + off + co) = w; } }
                ss += __shfl_xor(ss, 16); ss += __shfl_xor(ss, 32);
                if (fq == 0) ssp[(size_t)row * 16 + u.pn * 4 + wc] = ss; }
    }
};

struct EpiOutNorm {
    static constexpr bool PERM = false, AFTER_DRAIN = false, HAS_MID = false;
    const float* xin; float* out; const float* fg; float* xbuf; unsigned* cnt; PG8_LAS unsigned char* lx;
    __device__ __forceinline__ void operator()(f32x4 (&acc)[2][2][4][2], const Unit& u, int wr, int wc, int fr, int fq) const {
        PG8_LAS float* P = (PG8_LAS float*)lx;
        PG8_LAS float* S = (PG8_LAS float*)(lx + 4096);
        const int col0 = u.pn * BM + wc * 32 + 4 * fq, wid = wr * 4 + wc, lane = fq * 16 + fr;
#pragma unroll
        for (int ai = 0; ai < 2; ++ai)
#pragma unroll
            for (int m = 0; m < 4; ++m) { const int rl = ai * HALF + wr * 64 + m * 16 + fr; const size_t off = (size_t)(u.pm * BM + rl) * 1024 + col0; float ss = 0.f;
#pragma unroll
                for (int bj = 0; bj < 2; ++bj)
#pragma unroll
                    for (int n = 0; n < 2; ++n) { const f32x4 v = *(const f32x4*)(xin + off + bj * HALF + n * 16) + acc[ai][bj][m][n]; acc[ai][bj][m][n] = v;
                        ss += (v[0] * v[0] + v[1] * v[1]) + (v[2] * v[2] + v[3] * v[3]); }
                ss += __shfl_xor(ss, 16); ss += __shfl_xor(ss, 32);
                if (fq == 0) P[rl * 4 + wc] = ss;
                if (m & 1) asm volatile("" ::: "memory"); }
        asm volatile("s_waitcnt lgkmcnt(0)" ::: "memory"); __builtin_amdgcn_s_barrier(); asm volatile("" ::: "memory");
        const int rowl = wid * 32 + (lane & 31);
        if (lane < 32) { const float ts = (P[rowl * 4 + 0] + P[rowl * 4 + 1]) + (P[rowl * 4 + 2] + P[rowl * 4 + 3]);
            __hip_atomic_store(xbuf + ((size_t)(u.pm * BM + rowl) * 4 + u.pn), ts, __ATOMIC_RELAXED, __HIP_MEMORY_SCOPE_AGENT); }
        asm volatile("s_waitcnt vmcnt(0)" ::: "memory");
        if (lane == 0) __hip_atomic_fetch_add(cnt + 64 * u.pm, 1u, __ATOMIC_RELAXED, __HIP_MEMORY_SCOPE_AGENT);
        if (wid == 0) { unsigned spins = 0;
            while ((unsigned)__builtin_amdgcn_readfirstlane(__hip_atomic_load(cnt + 64 * u.pm, __ATOMIC_RELAXED, __HIP_MEMORY_SCOPE_AGENT)) < 32u) { __builtin_amdgcn_s_sleep(2); if (++spins > (1u << 22)) break; }
            __builtin_amdgcn_fence(__ATOMIC_ACQUIRE, "agent"); }
        asm volatile("s_waitcnt vmcnt(0) lgkmcnt(0)" ::: "memory"); __builtin_amdgcn_s_barrier(); asm volatile("" ::: "memory");
        if (lane < 32) { const float* slot = xbuf + (size_t)(u.pm * BM + rowl) * 4; float q = 0.f;
#pragma unroll
            for (int t = 0; t < 4; ++t) q += __hip_atomic_load(slot + t, __ATOMIC_RELAXED, __HIP_MEMORY_SCOPE_AGENT);
            S[rowl] = __builtin_amdgcn_rsqf(q * (1.0f / 1024.0f) + RMS_EPS_F); }
        asm volatile("s_waitcnt lgkmcnt(0)" ::: "memory"); __builtin_amdgcn_s_barrier(); asm volatile("" ::: "memory");
        f32x4 gv[2][2];
#pragma unroll
        for (int bj = 0; bj < 2; ++bj)
#pragma unroll
            for (int n = 0; n < 2; ++n) gv[bj][n] = *(const f32x4*)(fg + col0 + bj * HALF + n * 16);
#pragma unroll
        for (int ai = 0; ai < 2; ++ai)
#pragma unroll
            for (int m = 0; m < 4; ++m) { const int rl = ai * HALF + wr * 64 + m * 16 + fr; const float rs = S[rl]; const size_t off = (size_t)(u.pm * BM + rl) * 1024 + col0;
#pragma unroll
                for (int bj = 0; bj < 2; ++bj)
#pragma unroll
                    for (int n = 0; n < 2; ++n) *(f32x4*)(out + off + bj * HALF + n * 16) = acc[ai][bj][m][n] * rs * gv[bj][n]; }
    }
};
template <class Epi, class Sched, bool ALIGN_EPI = false, bool SP2 = false>
__device__ __forceinline__ void gemm_phase(PG8_LAS unsigned char* lds, const Gemm g_in, const Sched& S, const Epi& E) {
    Gemm g = g_in; asm volatile("" : "+s"(g.A), "+s"(g.Bt));
    int tid_ = threadIdx.x; asm volatile("" : "+v"(tid_));
    const int tid = tid_, wid = __builtin_amdgcn_readfirstlane(tid >> 6), lane = tid & 63, wr = wid >> 2, wc = wid & 3, fr = lane & 15, fq = lane >> 4;
    const int K = g.K, nt = K / BK;
    unsigned voffA[2], voffB[2];
#pragma unroll
    for (int i = 0; i < 2; ++i) { int R, C; stage_rc(tid * 16 + i * 8192, R, C); const int Rb = Epi::PERM ? ((R & ~31) + perm32(R & 31)) : R;
        voffA[i] = (unsigned)(R * g.lda + C) * 2u; voffB[i] = (unsigned)(Rb * g.ldb + C) * 2u; }
    const size_t kstep = (size_t)(BK * 2);
    const size_t hstepA = (size_t)HALF * g.lda * 2, hstepB = (size_t)HALF * g.ldb * 2;
    const size_t tstepA = 2 * hstepA, tstepB = 2 * hstepB;
    const unsigned ldsw = (unsigned)wid * 1024u;
    const int aoff = lds_byte(wr * 64 + fr, fq * 8), boff = lds_byte(wc * 32 + fr, fq * 8);
#define PG8_SA(b, h) (((b) * 2 + (h)) * HTB)
#define PG8_SB(b, h) ((4 + (b) * 2 + (h)) * HTB)
#define PG8_STAGE(bufoff, gbase, voff) do { _Pragma("unroll") for (int _i = 0; _i < 2; ++_i) \
        __builtin_amdgcn_global_load_lds((const unsigned*)((const char*)(gbase) + (voff)[_i]), (PG8_LAS unsigned*)(lds + (bufoff) + ldsw + _i * 8192), 16, 0, 0); } while (0)
#define PG8_LDA(dst, b, h) do { _Pragma("unroll") for (int m = 0; m < 4; ++m) _Pragma("unroll") for (int k = 0; k < 2; ++k) dst[m][k] = *(const PG8_LAS bf16x8*)(lds + PG8_SA(b, h) + aoff + m * 2048 + k * 1024); } while (0)
#define PG8_LDB(dst, b, h) do { _Pragma("unroll") for (int n = 0; n < 2; ++n) _Pragma("unroll") for (int k = 0; k < 2; ++k) dst[n][k] = *(const PG8_LAS bf16x8*)(lds + PG8_SB(b, h) + boff + n * 2048 + k * 1024); } while (0)
#define PG8_MMA(ai, bj, At, Bt) do { __builtin_amdgcn_s_setprio(1); _Pragma("unroll") for (int m = 0; m < 4; ++m) _Pragma("unroll") for (int n = 0; n < 2; ++n) _Pragma("unroll") for (int k = 0; k < 2; ++k) \
        acc[ai][bj][m][n] = __builtin_amdgcn_mfma_f32_16x16x32_bf16(Bt[n][k], At[m][k], acc[ai][bj][m][n], 0, 0, 0); __builtin_amdgcn_s_setprio(0); } while (0)
#define PG8_WAIT_V(n) asm volatile("s_waitcnt vmcnt(" #n ")" ::: "memory")
#define PG8_WAIT_L(n) asm volatile("s_waitcnt lgkmcnt(" #n ")" ::: "memory")
#define PG8_BAR __builtin_amdgcn_s_barrier()
#define PG8_SCHED __builtin_amdgcn_sched_barrier(0)
    Unit cur, nxt; int ui = 0;
    if (!S.next(0, cur)) return;
    f32x4 acc[2][2][4][2];
#pragma unroll
    for (int a = 0; a < 2; ++a)
#pragma unroll
        for (int b = 0; b < 2; ++b)
#pragma unroll
            for (int m = 0; m < 4; ++m)
#pragma unroll
                for (int n = 0; n < 2; ++n) acc[a][b][m][n] = (f32x4){0.f, 0.f, 0.f, 0.f};
    bf16x8 At[4][2], B0[2][2], B1[2][2];
    const char* cA = (const char*)g.A + (size_t)cur.pm * tstepA; const char* cB = (const char*)g.Bt + (size_t)cur.pn * tstepB;
    S.a_ready(cur);
    if constexpr (SP2) {
        PG8_STAGE(PG8_SB(0, 0), cB, voffB); PG8_STAGE(PG8_SB(0, 1), cB + hstepB, voffB); PG8_STAGE(PG8_SA(0, 0), cA, voffA); PG8_STAGE(PG8_SA(0, 1), cA + hstepA, voffA);
        if (wr == 1) PG8_BAR;
        PG8_WAIT_V(2); PG8_BAR;
        PG8_STAGE(PG8_SB(1, 0), cB + kstep, voffB); PG8_STAGE(PG8_SA(1, 0), cA + kstep, voffA); PG8_STAGE(PG8_SB(1, 1), cB + hstepB + kstep, voffB);
        PG8_WAIT_V(6); PG8_BAR;
    } else {
        PG8_STAGE(PG8_SB(0, 0), cB, voffB); PG8_STAGE(PG8_SA(0, 0), cA, voffA); PG8_STAGE(PG8_SB(0, 1), cB + hstepB, voffB); PG8_STAGE(PG8_SA(0, 1), cA + hstepA, voffA);
        if (wr == 1) PG8_BAR;
        PG8_WAIT_V(4); PG8_BAR;
        PG8_STAGE(PG8_SB(1, 0), cB + kstep, voffB); PG8_STAGE(PG8_SA(1, 0), cA + kstep, voffA); PG8_STAGE(PG8_SB(1, 1), cB + hstepB + kstep, voffB);
        PG8_WAIT_V(6); PG8_BAR;
    }
    for (;;) {
        const bool has_next = S.next(ui + 1, nxt);
        const char* nA = has_next ? (const char*)g.A + (size_t)nxt.pm * tstepA : cA; const char* nB = has_next ? (const char*)g.Bt + (size_t)nxt.pn * tstepB : cB;
        for (int t = 0; t < nt; t += 2) {
            if constexpr (Epi::HAS_MID) { if (t == (nt >> 1)) { int fr_ = fr, fq_ = fq; asm volatile("" : "+v"(fr_), "+v"(fq_)); E.mid(acc, cur, wr, wc, fr_, fq_); } }
            const bool last = (t == nt - 2);
            const char* a1 = cA + (size_t)(t + 1) * kstep;
            const char* a2 = last ? nA : cA + (size_t)(t + 2) * kstep; const char* b2 = last ? nB : cB + (size_t)(t + 2) * kstep;
            const char* a3 = a2 + kstep; const char* b3 = b2 + kstep;
            if (last && has_next) S.a_ready(nxt);
            if constexpr (SP2) {
            PG8_LDB(B0, 0, 0); PG8_LDB(B1, 0, 1); PG8_SCHED; PG8_LDA(At, 0, 0); PG8_STAGE(PG8_SA(1, 1), a1 + hstepA, voffA);
            PG8_WAIT_V(8); PG8_WAIT_L(0); PG8_BAR; PG8_MMA(0, 0, At, B0); PG8_MMA(0, 1, At, B1); PG8_BAR; PG8_SCHED;
            PG8_LDA(At, 0, 1); PG8_STAGE(PG8_SB(0, 0), b2, voffB); PG8_STAGE(PG8_SB(0, 1), b2 + hstepB, voffB); PG8_STAGE(PG8_SA(0, 0), a2, voffA);
            PG8_WAIT_V(8); PG8_WAIT_L(0); PG8_BAR; PG8_MMA(1, 0, At, B0); PG8_MMA(1, 1, At, B1); PG8_BAR; PG8_SCHED;
            PG8_LDB(B0, 1, 0); PG8_LDB(B1, 1, 1); PG8_SCHED; PG8_LDA(At, 1, 0); PG8_STAGE(PG8_SA(0, 1), a2 + hstepA, voffA);
            PG8_WAIT_V(8); PG8_WAIT_L(0); PG8_BAR; PG8_MMA(0, 0, At, B0); PG8_MMA(0, 1, At, B1); PG8_BAR; PG8_SCHED;
            PG8_LDA(At, 1, 1); PG8_STAGE(PG8_SB(1, 0), b3, voffB); PG8_STAGE(PG8_SB(1, 1), b3 + hstepB, voffB); PG8_STAGE(PG8_SA(1, 0), a3, voffA);
            PG8_WAIT_V(8); PG8_WAIT_L(0); PG8_BAR; PG8_MMA(1, 0, At, B0); PG8_MMA(1, 1, At, B1); PG8_BAR; PG8_SCHED;
            } else {
            PG8_LDB(B0, 0, 0); PG8_SCHED; PG8_LDA(At, 0, 0); PG8_STAGE(PG8_SA(1, 1), a1 + hstepA, voffA);
            PG8_WAIT_L(8); PG8_BAR; PG8_WAIT_L(0); PG8_MMA(0, 0, At, B0); PG8_BAR; PG8_SCHED;
            PG8_LDB(B1, 0, 1); PG8_STAGE(PG8_SB(0, 0), b2, voffB);
            PG8_BAR; PG8_WAIT_L(0); PG8_MMA(0, 1, At, B1); PG8_BAR;
            PG8_LDA(At, 0, 1); PG8_STAGE(PG8_SA(0, 0), a2, voffA);
            PG8_BAR; PG8_WAIT_L(0); PG8_MMA(1, 0, At, B0); PG8_BAR; PG8_SCHED;
            PG8_STAGE(PG8_SB(0, 1), b2 + hstepB, voffB);
            PG8_WAIT_V(6); PG8_BAR; PG8_MMA(1, 1, At, B1); PG8_BAR;
            PG8_LDB(B0, 1, 0); PG8_SCHED; PG8_LDA(At, 1, 0); PG8_STAGE(PG8_SA(0, 1), a2 + hstepA, voffA);
            PG8_WAIT_L(8); PG8_BAR; PG8_WAIT_L(0); PG8_MMA(0, 0, At, B0); PG8_BAR; PG8_SCHED;
            PG8_LDB(B1, 1, 1); PG8_STAGE(PG8_SB(1, 0), b3, voffB);
            PG8_BAR; PG8_WAIT_L(0); PG8_MMA(0, 1, At, B1); PG8_BAR;
            PG8_LDA(At, 1, 1); PG8_STAGE(PG8_SA(1, 0), a3, voffA);
            PG8_BAR; PG8_WAIT_L(0); PG8_MMA(1, 0, At, B0); PG8_BAR; PG8_SCHED;
            PG8_STAGE(PG8_SB(1, 1), b3 + hstepB, voffB);
            PG8_WAIT_V(6); PG8_BAR; PG8_MMA(1, 1, At, B1); PG8_BAR;
            }
        }
        if constexpr (ALIGN_EPI) { if (wr == 0) PG8_BAR; }
        if constexpr (!Epi::AFTER_DRAIN) { int fr_ = fr, fq_ = fq; asm volatile("" : "+v"(fr_), "+v"(fq_));   E(acc, cur, wr, wc, fr_, fq_); S.done(cur); }
        if (!has_next) break;
#pragma unroll
        for (int a = 0; a < 2; ++a)
#pragma unroll
            for (int b = 0; b < 2; ++b)
#pragma unroll
                for (int m = 0; m < 4; ++m)
#pragma unroll
                    for (int n = 0; n < 2; ++n) acc[a][b][m][n] = (f32x4){0.f, 0.f, 0.f, 0.f};
        cur = nxt; cA = nA; cB = nB; ++ui;
        if constexpr (ALIGN_EPI) { if (wr == 1) PG8_BAR; }
    }
    PG8_WAIT_V(0);
    if constexpr (!ALIGN_EPI) { if (wr == 0) PG8_BAR; }
    PG8_BAR;
    if constexpr (Epi::AFTER_DRAIN) { E.fused(acc, cur, wr, wc, fr, fq, lds, wid, lane); S.done(cur); }
#undef PG8_SA
#undef PG8_SB
#undef PG8_STAGE
#undef PG8_LDA
#undef PG8_LDB
#undef PG8_MMA
#undef PG8_WAIT_V
#undef PG8_WAIT_L
#undef PG8_BAR
#undef PG8_SCHED
}
}
#define LAS __attribute__((address_space(3)))
typedef unsigned short bf16;
typedef unsigned v4u __attribute__((ext_vector_type(4)));
typedef unsigned v2u __attribute__((ext_vector_type(2)));
typedef float f32x4 __attribute__((ext_vector_type(4)));
typedef float f32x16 __attribute__((ext_vector_type(16)));
typedef short bf16x8 __attribute__((ext_vector_type(8)));
typedef short s16x4 __attribute__((ext_vector_type(4)));
constexpr int NB = 4, SEQ = 8192, DM = 1024, T = NB * SEQ, NIN = 5120, NH = 8;
constexpr size_t MiB = 1u << 20;
constexpr size_t WS_BAR = 0, WS_PCNT = 16384, BAR_ZERO_BYTES = 65536;
constexpr size_t WS_XBUF = 3 * MiB;
constexpr size_t WS_SSP = 1 * MiB;
constexpr size_t WS_W = 4 * MiB, W_LAYER = 14 * MiB;
constexpr size_t WS_XG = 32 * MiB;
constexpr size_t WS_VP = 96 * MiB, WS_ZP = 128 * MiB, WS_Q = 160 * MiB, WS_K = 192 * MiB, WS_V = 224 * MiB, WS_ZA = 256 * MiB;
constexpr size_t WS_G = 288 * MiB;
constexpr size_t WS_Y = 416 * MiB;
constexpr size_t WS_MG = WS_Q;
constexpr size_t WS_END = 480 * MiB;
constexpr int LDS_BYTES = 147456;
constexpr int LDS_XTAB = 131072;
constexpr int LDS_MISC = 139264;
constexpr int NWAVES = 8, NTHREADS = 512;
constexpr int REP_P0 = 1, REP_P1 = 1, REP_P2 = 1, REP_P3A = 1, REP_SYNC = 1, REP_P3B = 1, REP_FIN = 1;

__device__ __forceinline__ unsigned f2bf(float f) { unsigned u = __builtin_bit_cast(unsigned, f); return (u + 0x7fffu + ((u >> 16) & 1u)) >> 16; }
__device__ __forceinline__ unsigned pk2(float lo, float hi) { return f2bf(lo) | (f2bf(hi) << 16); }
typedef float f32x2_t __attribute__((ext_vector_type(2))); typedef __bf16 bf16x2_t __attribute__((ext_vector_type(2)));
__device__ __forceinline__ unsigned cvtpk(float lo, float hi) { f32x2_t v = {lo, hi}; bf16x2_t b = __builtin_convertvector(v, bf16x2_t); return __builtin_bit_cast(unsigned, b); }
__device__ __forceinline__ float bflo(unsigned u) { return __uint_as_float(u << 16); }
__device__ __forceinline__ float bfhi(unsigned u) { return __uint_as_float(u & 0xffff0000u); }
__device__ __forceinline__ float wave_sum(float v) {
#pragma unroll
    for (int o = 1; o < 64; o <<= 1) v += __shfl_xor(v, o);
    return v;
}
#define LDS_WAIT() asm volatile("s_waitcnt lgkmcnt(0)" ::: "memory")

__device__ __forceinline__ void tr_item(const float* W, int ldw, bf16* WT, int ldt, int k0, int n0, int trow0, int tcol0, LAS float* scr, int lane) {
#pragma unroll 8
    for (int i = 0; i < 32; ++i) { const int kk = 2 * i + (lane >> 5); scr[kk * 33 + (lane & 31)] = W[(size_t)(k0 + kk) * ldw + n0 + (lane & 31)]; }
    LDS_WAIT();
    const int c = lane & 7;
#pragma unroll
    for (int j = 0; j < 4; ++j) { const int n = (lane >> 3) + 8 * j; const LAS float* s = scr + (8 * c) * 33 + n;
        v4u o; o.x = pk2(s[0 * 33], s[1 * 33]); o.y = pk2(s[2 * 33], s[3 * 33]); o.z = pk2(s[4 * 33], s[5 * 33]); o.w = pk2(s[6 * 33], s[7 * 33]);
        *(v4u*)(WT + (size_t)(trow0 + n) * ldt + tcol0 + 8 * c) = o; }
    LDS_WAIT();
}

#define RLX_AGENT __ATOMIC_RELAXED, __HIP_MEMORY_SCOPE_AGENT
#define XB_TMO      128
#define XB_XCNT(j)  (256  + 64 * (j))
#define XB_XSUB(j)  (1280 + 64 * (j))
#define XB_XGEN(j)  (2304 + 64 * (j))
#define XB_TOP      3328
#define XB_TOPGEN   3392
#define XCD_BAR_WORDS 3456
#define XB_SPIN_CAP (1u << 18)

__device__ __forceinline__ unsigned xb_ld(unsigned* p)              { return __hip_atomic_load(p, __ATOMIC_RELAXED, __HIP_MEMORY_SCOPE_AGENT); }
__device__ __forceinline__ unsigned xb_add(unsigned* p, unsigned v) { return __hip_atomic_fetch_add(p, v, __ATOMIC_RELAXED, __HIP_MEMORY_SCOPE_AGENT); }
__device__ __forceinline__ unsigned xb_xcc_id() { return (unsigned)__builtin_amdgcn_s_getreg((3 << 11) | 20) & 0xFu; }
#define XB_SPIN(cond, bar) do { unsigned _sp = 0; while (cond) { __builtin_amdgcn_s_sleep(1); \
    if ((++_sp & 255u) == 0u) { if (xb_ld(&(bar)[XB_TMO])) break; if (_sp > XB_SPIN_CAP) { atomicAdd(&(bar)[XB_TMO], 1u); break; } } } } while (0)

struct XcdBarrier {
    unsigned* bar; unsigned x;
    volatile LAS unsigned* st;
};

__device__ __forceinline__ XcdBarrier xcd_barrier_post(unsigned* bar, volatile LAS unsigned* st) {
    XcdBarrier b; b.bar = bar; b.x = xb_xcc_id(); b.st = st;
    if (threadIdx.x == 0) (void)xb_add(&bar[XB_XCNT(b.x)], 1u);
    return b;
}
__device__ __forceinline__ void xcd_barrier_complete(unsigned* bar, unsigned x, unsigned& nloc, unsigned& nx) {
    const unsigned G = gridDim.x * gridDim.y * gridDim.z;
    unsigned sum, cnt, mine, sp = 0u;
    for (;;) {
        sum = 0u; cnt = 0u; mine = 0u;
#pragma unroll
        for (unsigned j = 0; j < 16; ++j) { const unsigned c = xb_ld(&bar[XB_XCNT(j)]); sum += c; cnt += (c > 0u) ? 1u : 0u; mine = (j == x) ? c : mine; }
        if (sum == G) break;
        __builtin_amdgcn_s_sleep(1);
        if ((++sp & 255u) == 0u) { if (xb_ld(&bar[XB_TMO])) break; if (sp > XB_SPIN_CAP) { atomicAdd(&bar[XB_TMO], 1u); break; } }
    }
    nloc = mine > 0u ? mine : 1u; nx = cnt > 0u ? cnt : 1u;
}

__device__ __forceinline__ void xcd_barrier(const XcdBarrier& b) {
    asm volatile("s_waitcnt vmcnt(0)" ::: "memory");
    __syncthreads();
    if (threadIdx.x == 0) {
        unsigned* bar = b.bar;
        __builtin_amdgcn_s_waitcnt(0);
        unsigned nloc = b.st[0], nx = b.st[1];
        if (nloc == 0u) { xcd_barrier_complete(bar, b.x, nloc, nx); b.st[0] = nloc; b.st[1] = nx; }
        const unsigned old = xb_add(&bar[XB_XSUB(b.x)], 1u);
        const unsigned gen = old / nloc;
        if (old + 1u == (gen + 1u) * nloc) {
            __builtin_amdgcn_fence(__ATOMIC_RELEASE, "agent");
            asm volatile("s_waitcnt vmcnt(0)" ::: "memory");
            const unsigned og = xb_add(&bar[XB_TOP], 1u);
            const unsigned tg = og / nx;
            if (og + 1u == (tg + 1u) * nx) xb_add(&bar[XB_TOPGEN], 1u);
            else XB_SPIN(xb_ld(&bar[XB_TOPGEN]) == tg, bar);
            __builtin_amdgcn_fence(__ATOMIC_ACQUIRE, "agent");
            xb_add(&bar[XB_XGEN(b.x)], 1u);
            asm volatile("s_waitcnt vmcnt(0)" ::: "memory");
        } else {
            XB_SPIN(xb_ld(&bar[XB_XGEN(b.x)]) == gen, bar);
            __builtin_amdgcn_fence(__ATOMIC_ACQUIRE, "agent");
            asm volatile("s_waitcnt vmcnt(0)" ::: "memory");
        }
    }
    __syncthreads();
}
constexpr int VPITCH = 144;
constexpr float SB_EXIT = 1.17549435e-38f;
__device__ __forceinline__ int crow(int r, int hi) { return (r & 3) + 8 * (r >> 2) + 4 * hi; }
__device__ __forceinline__ s16x4 vtr(const LAS unsigned char* p) { typedef short v4i16_t __attribute__((ext_vector_type(4)));
    return __builtin_bit_cast(s16x4, __builtin_amdgcn_ds_read_tr16_b64_v4i16((LAS v4i16_t*)p)); }
__device__ __forceinline__ void attn_unit(const bf16* __restrict__ Q, const bf16* __restrict__ K, const bf16* __restrict__ V, const bf16* __restrict__ ZA, bf16* __restrict__ Y,
                                          int b, int h, int qt, LAS unsigned char* vl, int lane) {
    const int j = lane & 31, hi = lane >> 5;
    const size_t row0 = (size_t)b * SEQ + (size_t)qt * 32;
    const bf16* qp = Q + (row0 + j) * 512 + h * 64 + 8 * hi;
    bf16x8 qf[4];
#pragma unroll
    for (int s = 0; s < 4; ++s) qf[s] = *(const bf16x8*)(qp + 16 * s);
    f32x16 o0, o1;
#pragma unroll
    for (int r = 0; r < 16; ++r) { o0[r] = 0.f; o1[r] = 0.f; }
    float pc = 1.0f;
    const int blk = (lane >> 4) & 1, q4 = (lane & 15) >> 2, p4 = lane & 3;
    const unsigned trb = (unsigned)((4 * hi + q4) * VPITCH + (16 * blk + 4 * p4) * 2);
    const unsigned vwb = (unsigned)((lane >> 3) * VPITCH + (lane & 7) * 16);
    const bf16* kp = K + ((size_t)b * SEQ + (size_t)qt * 32 + j) * 512 + h * 64 + 8 * hi;
    const bf16* vp = V + ((size_t)b * SEQ + (size_t)qt * 32 + (lane >> 3)) * 512 + h * 64 + (lane & 7) * 8;
    bf16x8 kf[4], kfn[4]; v4u vv[4], vvn[4];
#pragma unroll
    for (int s = 0; s < 4; ++s) kf[s] = *(const bf16x8*)(kp + 16 * s);
#pragma unroll
    for (int i = 0; i < 4; ++i) vv[i] = *(const v4u*)(vp + (size_t)i * 8 * 512);
    for (int kt = qt; kt >= 0; --kt) {
        if (kt > 0) {
            kp -= 32 * 512; vp -= 32 * 512;
#pragma unroll
            for (int s = 0; s < 4; ++s) kfn[s] = *(const bf16x8*)(kp + 16 * s);
#pragma unroll
            for (int i = 0; i < 4; ++i) vvn[i] = *(const v4u*)(vp + (size_t)i * 8 * 512);
        }
        f32x16 sc;
#pragma unroll
        for (int r = 0; r < 16; ++r) sc[r] = 0.f;
#pragma unroll
        for (int s = 0; s < 4; ++s) sc = __builtin_amdgcn_mfma_f32_32x32x16_bf16(kf[s], qf[s], sc, 0, 0, 0);
        asm volatile("" ::: "memory");
#pragma unroll
        for (int i = 0; i < 4; ++i) *(LAS v4u*)(vl + vwb + i * 8 * VPITCH) = vv[i];
        asm volatile("" ::: "memory");
        const bool diag = (kt == qt);
        float be[16], om[16];
#pragma unroll
        for (int r = 0; r < 16; ++r) { const float e = __builtin_amdgcn_exp2f(-__builtin_fmaxf(sc[r], -126.0f)); const float bb = __builtin_amdgcn_rcpf(1.0f + e);
            be[r] = bb; om[r] = e * bb; }
        if (diag) {
#pragma unroll
            for (int r = 0; r < 16; ++r) if (crow(r, hi) >= j) { be[r] = 0.f; om[r] = 1.0f; } }
        float Rp[4], Tt[4];
#pragma unroll
        for (int a = 0; a < 4; ++a) { const float R = (om[4 * a] * om[4 * a + 1]) * (om[4 * a + 2] * om[4 * a + 3]); Rp[a] = __shfl_xor(R, 32); Tt[a] = R * Rp[a]; }
        float suf = pc; float w[16];
#pragma unroll
        for (int a = 3; a >= 0; --a) { float c = (hi == 0) ? suf * Rp[a] : suf;
            w[4 * a + 3] = be[4 * a + 3] * c; c *= om[4 * a + 3];
            w[4 * a + 2] = be[4 * a + 2] * c; c *= om[4 * a + 2];
            w[4 * a + 1] = be[4 * a + 1] * c; c *= om[4 * a + 1];
            w[4 * a] = be[4 * a] * c;
            suf *= Tt[a]; }
        pc = suf;
        bf16x8 pf[2];
#pragma unroll
        for (int s = 0; s < 2; ++s) { v4u p; p.x = cvtpk(w[8 * s], w[8 * s + 1]); p.y = cvtpk(w[8 * s + 2], w[8 * s + 3]); p.z = cvtpk(w[8 * s + 4], w[8 * s + 5]); p.w = cvtpk(w[8 * s + 6], w[8 * s + 7]);
            pf[s] = __builtin_bit_cast(bf16x8, p); }
#pragma unroll
        for (int s = 0; s < 2; ++s) {
            { const s16x4 lo = vtr(vl + trb + (16 * s) * VPITCH), hh = vtr(vl + trb + (16 * s + 8) * VPITCH);
              const bf16x8 vf = (bf16x8){lo[0], lo[1], lo[2], lo[3], hh[0], hh[1], hh[2], hh[3]};
              o0 = __builtin_amdgcn_mfma_f32_32x32x16_bf16(vf, pf[s], o0, 0, 0, 0); }
            { const s16x4 lo = vtr(vl + trb + (16 * s) * VPITCH + 64), hh = vtr(vl + trb + (16 * s + 8) * VPITCH + 64);
              const bf16x8 vf = (bf16x8){lo[0], lo[1], lo[2], lo[3], hh[0], hh[1], hh[2], hh[3]};
              o1 = __builtin_amdgcn_mfma_f32_32x32x16_bf16(vf, pf[s], o1, 0, 0, 0); }
        }
        asm volatile("" ::: "memory");
        if (__ballot(pc >= SB_EXIT) == 0ull) break;
#pragma unroll
        for (int s = 0; s < 4; ++s) { kf[s] = kfn[s]; vv[s] = vvn[s]; }
    }
    const size_t zrow = (row0 + j) * 512 + h * 64, yrow = (row0 + j) * 1024 + 512 + h * 64;
#pragma unroll
    for (int a = 0; a < 4; ++a) { const int d0 = 8 * a + 4 * hi;
        { const v2u zz = *(const v2u*)(ZA + zrow + d0); v2u o; o.x = cvtpk(o0[4 * a] * bflo(zz.x), o0[4 * a + 1] * bfhi(zz.x)); o.y = cvtpk(o0[4 * a + 2] * bflo(zz.y), o0[4 * a + 3] * bfhi(zz.y));
          *(v2u*)(Y + yrow + d0) = o; }
        { const v2u zz = *(const v2u*)(ZA + zrow + 32 + d0); v2u o; o.x = cvtpk(o1[4 * a] * bflo(zz.x), o1[4 * a + 1] * bfhi(zz.x)); o.y = cvtpk(o1[4 * a + 2] * bflo(zz.y), o1[4 * a + 3] * bfhi(zz.y));
          *(v2u*)(Y + yrow + 32 + d0) = o; } }
}

__device__ __forceinline__ void unpack8(const v4u q, float (&f)[8]) { f[0] = bflo(q.x); f[1] = bfhi(q.x); f[2] = bflo(q.y); f[3] = bfhi(q.y); f[4] = bflo(q.z); f[5] = bfhi(q.z); f[6] = bflo(q.w); f[7] = bfhi(q.w); }
template <int W> __device__ __forceinline__ void pool_wave_task(const bf16* __restrict__ VP, const bf16* __restrict__ ZP, bf16* __restrict__ Y, int g, int tblk, int lane) {
    const int t0 = tblk * 32 + (lane >> 4) * 8, pos0 = t0 & (SEQ - 1), ch = g * 128 + (lane & 15) * 8;
    const bf16* vp = VP + (size_t)t0 * 512 + ch; const bf16* zp = ZP + (size_t)t0 * 512 + ch; bf16* yp = Y + (size_t)t0 * 1024 + ch;
    v4u hv[W + 7], zv[8];
#pragma unroll
    for (int i = 0; i < W + 7; ++i) { const int off = i - (W - 1); hv[i] = (pos0 + off >= 0) ? *(const v4u*)(vp + (ptrdiff_t)off * 512) : (v4u){0u, 0u, 0u, 0u}; }
#pragma unroll
    for (int t = 0; t < 8; ++t) zv[t] = *(const v4u*)(zp + (size_t)t * 512);
    float s[8];
#pragma unroll
    for (int e = 0; e < 8; ++e) s[e] = 0.f;
#pragma unroll
    for (int i = 0; i < W - 1; ++i) { float f[8]; unpack8(hv[i], f);
#pragma unroll
        for (int e = 0; e < 8; ++e) s[e] += f[e]; }
#pragma unroll
    for (int t = 0; t < 8; ++t) { float v[8], z[8], y[8]; unpack8(hv[W - 1 + t], v); unpack8(zv[t], z);
        const int cnt = (pos0 + t + 1 < W) ? pos0 + t + 1 : W; const float inv = __builtin_amdgcn_rcpf((float)cnt);
#pragma unroll
        for (int e = 0; e < 8; ++e) { s[e] += v[e]; y[e] = (s[e] * inv - v[e]) * z[e]; }
        v4u o; o.x = cvtpk(y[0], y[1]); o.y = cvtpk(y[2], y[3]); o.z = cvtpk(y[4], y[5]); o.w = cvtpk(y[6], y[7]);
        *(v4u*)(yp + (size_t)t * 1024) = o;
        float f[8]; unpack8(hv[t], f);
#pragma unroll
        for (int e = 0; e < 8; ++e) s[e] -= f[e]; }
}

struct Args { const float* in[10]; float* out; unsigned char* ws; };
__global__ void __launch_bounds__(NTHREADS, 2) fwd_megakernel(Args args) {
    extern __shared__ __attribute__((aligned(16))) unsigned char lds_raw[];
    LAS unsigned char* lds = (LAS unsigned char*)lds_raw;
    const int tid = threadIdx.x, lane = tid & 63, wave = __builtin_amdgcn_readfirstlane(tid >> 6);
    const int G = gridDim.x, bx = blockIdx.x, vcu = (G % 8 == 0) ? (bx % 8) * (G / 8) + bx / 8 : bx;
    const int gw = vcu * NWAVES + wave, NGW = G * NWAVES;
    volatile LAS unsigned* MISC = (volatile LAS unsigned*)(lds + LDS_MISC);
    if (tid < 4) MISC[tid] = 0u;
    __syncthreads();
    const XcdBarrier bar = xcd_barrier_post((unsigned*)(args.ws + WS_BAR), MISC);
    const float* x = args.in[0]; const float* norm_g = args.in[1]; const float* w_in = args.in[2]; const float* b_gate = args.in[3]; const float* pool_w = args.in[4];
    const float* pool_scale = args.in[5]; const float* w_pool_up = args.in[6]; const float* w_attn_up = args.in[7]; const float* w_out = args.in[8]; const float* final_g = args.in[9];
    float* out = args.out; unsigned char* ws = args.ws;
    float* SSP = (float*)(ws + WS_SSP);
    bf16* XG = (bf16*)(ws + WS_XG); bf16* VP = (bf16*)(ws + WS_VP); bf16* ZP = (bf16*)(ws + WS_ZP); bf16* Qb = (bf16*)(ws + WS_Q); bf16* Kb = (bf16*)(ws + WS_K);
    bf16* Vb = (bf16*)(ws + WS_V); bf16* ZA = (bf16*)(ws + WS_ZA); bf16* Gt = (bf16*)(ws + WS_G); bf16* Yb = (bf16*)(ws + WS_Y); bf16* MG = (bf16*)(ws + WS_MG);

#pragma nounroll
    for (int rep = 0; rep < REP_P0; ++rep) {
        LAS float* PW = (LAS float*)lds; LAS float* WI = (LAS float*)(lds + 65536);
        for (int it = vcu; it < 256; it += G) {
            const int l = it >> 7, g = (it >> 5) & 3, k0 = (it & 31) * 32;
            const float* pw = pool_w + ((size_t)l * 4 + g) * 16384; const float* wi = w_in + (size_t)l * DM * NIN + (size_t)k0 * NIN + g * 128;
            __syncthreads();
#pragma unroll 4
            for (int i = 0; i < 32; ++i) PW[tid + 512 * i] = pw[tid + 512 * i];
#pragma unroll
            for (int i = 0; i < 8; ++i) { const int idx = tid + 512 * i; WI[idx] = wi[(size_t)(idx >> 7) * NIN + (idx & 127)]; }
            __syncthreads();
            const int d = tid & 127, kq = tid >> 7; float acc[8];
#pragma unroll
            for (int e = 0; e < 8; ++e) acc[e] = 0.f;
            for (int c = 0; c < 128; ++c) { const float p = PW[c * 128 + d];
#pragma unroll
                for (int e = 0; e < 8; ++e) acc[e] += WI[(kq * 8 + e) * 128 + c] * p; }
            const float sc = pool_scale[l * 512 + g * 128 + d];
            v4u o; o.x = pk2(acc[0] * sc, acc[1] * sc); o.y = pk2(acc[2] * sc, acc[3] * sc); o.z = pk2(acc[4] * sc, acc[5] * sc); o.w = pk2(acc[6] * sc, acc[7] * sc);
            bf16* wt = (bf16*)(ws + WS_W + (size_t)l * W_LAYER);
            *(v4u*)(wt + (size_t)(g * 128 + d) * 1024 + k0 + kq * 8) = o;
        }
        __syncthreads();
        LAS float* scr = (LAS float*)(lds + wave * 16384);
        for (int it = gw; it < 6656; it += NGW) {
            const int l = it / 3328; int r = it % 3328;
            bf16* win_t = (bf16*)(ws + WS_W + (size_t)l * W_LAYER); bf16* wpa_t = win_t + (size_t)NIN * 1024; bf16* wout_t = wpa_t + (size_t)1024 * 1024;
            if (r < 2304) { const int kb = r / 144, nb = r % 144; tr_item(w_in + (size_t)l * DM * NIN, NIN, win_t, 1024, kb * 64, 512 + nb * 32, 512 + nb * 32, kb * 64, scr, lane); continue; } r -= 2304;
            if (r < 256) { const int kb = r / 32, nb = r % 32; tr_item(w_pool_up + (size_t)l * 512 * 1024, 1024, wpa_t, 1024, kb * 64, nb * 32, nb * 32, kb * 64, scr, lane); continue; } r -= 256;
            if (r < 256) { const int kb = r / 32, nb = r % 32; tr_item(w_attn_up + (size_t)l * 512 * 1024, 1024, wpa_t, 1024, kb * 64, nb * 32, nb * 32, 512 + kb * 64, scr, lane); continue; } r -= 256;
            { const int kb = r / 32, nb = r % 32; tr_item(w_out + (size_t)l * 1024 * 1024, 1024, wout_t, 1024, kb * 64, nb * 32, nb * 32, kb * 64, scr, lane); }
        }
        for (int m = gw; m < T; m += NGW) {
            const f32x4* xr = (const f32x4*)(x + (size_t)m * DM) + lane; const f32x4* gr = (const f32x4*)norm_g + lane;
            f32x4 v[4]; float s = 0.f;
#pragma unroll
            for (int jx = 0; jx < 4; ++jx) { v[jx] = xr[64 * jx]; s += (v[jx][0] * v[jx][0] + v[jx][1] * v[jx][1]) + (v[jx][2] * v[jx][2] + v[jx][3] * v[jx][3]); }
            s = wave_sum(s);
            v2u* o8 = (v2u*)(XG + (size_t)m * DM) + lane;
#pragma unroll
            for (int jx = 0; jx < 4; ++jx) { const f32x4 gg = gr[64 * jx]; v2u o; o.x = pk2(v[jx][0] * gg[0], v[jx][1] * gg[1]); o.y = pk2(v[jx][2] * gg[2], v[jx][3] * gg[3]); o8[64 * jx] = o; }
            if (lane < 16) SSP[(size_t)m * 16 + lane] = (lane == 0) ? s : 0.f;
        }
    }
    xcd_barrier(bar);

    for (int l = 0; l < 2; ++l) {
        const bf16* win_t = (const bf16*)(ws + WS_W + (size_t)l * W_LAYER); const bf16* wpa_t = win_t + (size_t)NIN * 1024; const bf16* wout_t = wpa_t + (size_t)1024 * 1024;
#pragma nounroll
        for (int rep = 0; rep < REP_P1; ++rep) {   pg8::Gemm g{XG, win_t, T, NIN, DM, DM, DM}; pg8::StaticOrder S; S.init(T, NIN, G, bx);
            pg8::EpiProj E{VP, ZP, Qb, Kb, Vb, ZA, Gt, SSP, b_gate + l * 2048};
            pg8::gemm_phase<pg8::EpiProj, pg8::StaticOrder, true, true>(lds, g, S, E); }
#pragma nounroll
        for (int rep = 0; rep < REP_SYNC; ++rep) xcd_barrier(bar);
#pragma nounroll
        for (int rep = 0; rep < REP_P2; ++rep) {   LAS unsigned char* vl = lds + wave * 8192;
            int ln = lane; asm volatile("" : "+v"(ln));
            for (int u = gw; u < NB * NH * (SEQ / 32); u += NGW) { const int qt = u & 255, bh = u >> 8; attn_unit(Qb, Kb, Vb, ZA, Yb, bh >> 3, bh & 7, qt, vl, ln); }
            for (int wt = gw; wt < (T / 32) * 4; wt += NGW) { const int g = wt & 3, tblk = wt >> 2;
                if (g == 0) pool_wave_task<2>(VP, ZP, Yb, 0, tblk, ln); else if (g == 1) pool_wave_task<4>(VP, ZP, Yb, 1, tblk, ln);
                else if (g == 2) pool_wave_task<8>(VP, ZP, Yb, 2, tblk, ln); else pool_wave_task<16>(VP, ZP, Yb, 3, tblk, ln); } }
        xcd_barrier(bar);
#pragma nounroll
        for (int rep = 0; rep < REP_P3A; ++rep) {   pg8::StaticOrder S; S.init(T, DM, G, bx);
            { pg8::Gemm g{Yb, wpa_t, T, DM, DM, DM, DM}; pg8::EpiMergeMid E{MG, Gt}; pg8::gemm_phase<pg8::EpiMergeMid, pg8::StaticOrder, true, true>(lds, g, S, E); } }
        xcd_barrier(bar);
        const bool fuse_norm = (l == 1 && G == 256);
        if (!fuse_norm) {
#pragma nounroll
        for (int rep = 0; rep < (l == 0 ? REP_P3B : 1); ++rep) {   pg8::Gemm g{MG, wout_t, T, DM, DM, DM, DM}; pg8::StaticOrder S; S.init(T, DM, G, bx);
            pg8::EpiOut E{l == 0 ? x : (const float*)out, out, XG, norm_g + 1024, SSP, l == 0 ? 1 : 0};
            pg8::gemm_phase<pg8::EpiOut, pg8::StaticOrder, true, true>(lds, g, S, E); }
        xcd_barrier(bar);
        } else {
            pg8::Gemm g{MG, wout_t, T, DM, DM, DM, DM}; pg8::StaticOrder S; S.init(T, DM, G, bx);
            pg8::EpiOutNorm E{out, out, final_g, (float*)(ws + WS_XBUF), (unsigned*)(ws + WS_PCNT), lds + LDS_XTAB};
            pg8::gemm_phase<pg8::EpiOutNorm, pg8::StaticOrder, true, true>(lds, g, S, E); }
    }
    if (G != 256) {
#pragma nounroll
    for (int rep = 0; rep < REP_FIN; ++rep)
    for (int m = gw; m < T; m += NGW) {
        float ss = SSP[(size_t)m * 16 + (lane & 15)];
        ss += __shfl_xor(ss, 1); ss += __shfl_xor(ss, 2); ss += __shfl_xor(ss, 4); ss += __shfl_xor(ss, 8);
        const float rstd = __builtin_amdgcn_rsqf(ss * (1.0f / 1024.0f) + 1e-6f);
        f32x4* xr = (f32x4*)(out + (size_t)m * DM) + lane; const f32x4* gr = (const f32x4*)final_g + lane;
        f32x4* xw = (rep == REP_FIN - 1) ? xr : (f32x4*)((float*)(ws + WS_G) + (size_t)m * DM) + lane;
#pragma unroll
        for (int jx = 0; jx < 4; ++jx) { const f32x4 v = xr[64 * jx]; xw[64 * jx] = v * rstd * gr[64 * jx]; }
    }
    }
}

extern "C" void kernel_launch(void* const* d_in, const int* in_sizes, int n_in, void* d_out, int out_size, void* d_ws, size_t ws_size, hipStream_t stream) {
    static int grid = 0;
    if (grid == 0) {
        if (n_in != 10 || in_sizes[0] != T * DM || out_size != T * DM || ws_size < WS_END) { fprintf(stderr, "kernel_launch: unexpected shapes / workspace (ws %zu, need %zu)\n", ws_size, (size_t)WS_END); grid = -1; return; }
        int dev = 0, cus = 0, per_cu = 0;
        hipGetDevice(&dev); hipDeviceGetAttribute(&cus, hipDeviceAttributeMultiprocessorCount, dev);
        hipFuncSetAttribute((const void*)fwd_megakernel, hipFuncAttributeMaxDynamicSharedMemorySize, LDS_BYTES);
        hipOccupancyMaxActiveBlocksPerMultiprocessor(&per_cu, (const void*)fwd_megakernel, NTHREADS, LDS_BYTES);
        if (per_cu < 1) { fprintf(stderr, "kernel_launch: occupancy query says %d blocks per CU\n", per_cu); per_cu = 1; }
        grid = cus * per_cu;
    }
    if (grid < 0) return;
    if (hipMemsetAsync((char*)d_ws + WS_BAR, 0, BAR_ZERO_BYTES, stream) != hipSuccess) { fprintf(stderr, "kernel_launch: memset of the barrier words failed\n"); return; }
    Args a{};
    for (int i = 0; i < 10; ++i) a.in[i] = (const float*)d_in[i];
    a.out = (float*)d_out; a.ws = (unsigned char*)d_ws;
    void* kargs[] = {&a};
    hipError_t e = hipLaunchCooperativeKernel((const void*)fwd_megakernel, dim3(grid), dim3(NTHREADS), kargs, LDS_BYTES, stream);
    if (e != hipSuccess) fprintf(stderr, "cooperative launch failed: %s (grid %d)\n", hipGetErrorString(e), grid);
}
```

```cpp
#include <hip/hip_runtime.h>
#include <cstdio>
#include <cstdint>
namespace pg8 {
#define PG8_LAS __attribute__((address_space(3)))
typedef unsigned short bf16_t;
typedef short bf16x8 __attribute__((ext_vector_type(8)));
typedef float f32x4 __attribute__((ext_vector_type(4)));
typedef unsigned u32x4 __attribute__((ext_vector_type(4)));
constexpr int BM = 256, BK = 64, HALF = 128, HTB = HALF * BK * 2  , STAGE_BYTES = 8 * HTB, NXCD = 8, WGM = 8;

__host__ __device__ __forceinline__ int lds_byte(int r, int c) { const int st = (r >> 4) * 2 + (c >> 5), rr = r & 15, cc = c & 31, ob = rr * 64 + cc * 2; return st * 1024 + (ob ^ (((ob >> 9) & 1) << 5)); }
__host__ __device__ __forceinline__ void stage_rc(int b, int& R, int& C) { const int st = b / 1024, sb = b % 1024, swz = sb ^ (((sb >> 9) & 1) << 5); R = (st >> 1) * 16 + swz / 64; C = (st & 1) * 32 + (swz % 64) / 2; }
__host__ __device__ __forceinline__ int perm32(int rho) { const int n = rho >> 4, i = rho & 15; return 8 * (i >> 2) + 4 * n + (i & 3); }

struct Unit { int pm, pn; };
struct Gemm { const bf16_t* A; const bf16_t* Bt; int M, N, K, lda, ldb; };

struct StaticOrder {
    int nM, nN, nwg, G, c;
    __host__ __device__ void init(int M, int N, int G_, int c_) { nM = M / BM; nN = N / BM; nwg = nM * nN; G = G_; c = c_; }
    __host__ __device__ bool next(int i, Unit& u) const {
        const long L = (long)i * G + c; if (L >= nwg) return false;
        int wgid = (int)L; { const int q = nwg / NXCD, r = nwg % NXCD, xcd = wgid % NXCD, off = wgid / NXCD; wgid = (xcd < r ? xcd * (q + 1) : r * (q + 1) + (xcd - r) * q) + off; }
        const int nig = WGM * nN, gid = wgid / nig, fm = gid * WGM, gsz = (nM - fm) < WGM ? (nM - fm) : WGM;
        u.pm = fm + ((wgid % nig) % gsz); u.pn = (wgid % nig) / gsz; return true;
    }
    __device__ __forceinline__ void a_ready(const Unit&) const {}
    __device__ __forceinline__ void done(const Unit&) const {}
};

__device__ __forceinline__ unsigned cvt_pk_bf16(float lo, float hi) { unsigned r; asm volatile("v_cvt_pk_bf16_f32 %0, %1, %2" : "=v"(r) : "v"(lo), "v"(hi)); return r; }
typedef float f32x2 __attribute__((ext_vector_type(2)));
__device__ __forceinline__ float bf_lo(unsigned u) { return __uint_as_float(u << 16); }
__device__ __forceinline__ float bf_hi(unsigned u) { return __uint_as_float(u & 0xffff0000u); }
__device__ __forceinline__ float sigmoid_f(float v) { return __builtin_amdgcn_rcpf(1.0f + __builtin_amdgcn_exp2f(-1.4426950408889634f * v)); }
constexpr float RMS_EPS_F = 1e-6f;
constexpr float QSCALE = 0.125f * 1.4426950408889634f;

struct EpiProj {
    static constexpr bool PERM = true, AFTER_DRAIN = false, HAS_MID = false;
    bf16_t *VP, *ZP, *Q, *K, *V, *ZA, *G; const float* ssp; const float* bgate;
    __device__ __forceinline__ void operator()(const f32x4 (&acc)[2][2][4][2], const Unit& u, int wr, int wc, int fr, int fq) const {
        const int pn = u.pn; bf16_t* base; int ld, mode, colt; float sc = 1.f;
        if (pn < 12) { const int seg = pn >> 1; colt = (pn & 1) * 256; ld = 512;
            base = seg == 0 ? VP : seg == 1 ? ZP : seg == 2 ? Q : seg == 3 ? K : seg == 4 ? V : ZA;
            mode = (seg == 1 || seg == 5) ? 1 : 0; if (seg == 2) sc = QSCALE; }
        else { base = G; colt = (pn - 12) * 256; ld = 2048; mode = 2; }
        const int row0 = u.pm * BM + wr * 64 + fr, col0 = colt + wc * 64 + 8 * fq;
        const int chan0 = (pn - 12) * 128 + wc * 32 + 8 * fq;
        f32x4 bv[2][2];
#pragma unroll
        for (int bj = 0; bj < 2; ++bj)
#pragma unroll
            for (int n = 0; n < 2; ++n) bv[bj][n] = (mode == 2) ? *(const f32x4*)(bgate + bj * 1024 + chan0 + 4 * n) * -1.4426950408889634f : (f32x4){0.f, 0.f, 0.f, 0.f};
#pragma unroll
        for (int ai = 0; ai < 2; ++ai)
#pragma unroll
            for (int m = 0; m < 4; ++m) { const int row = row0 + ai * HALF + m * 16;
                const f32x4 st = *((const f32x4*)(ssp + (size_t)row * 16) + fq);
                float ss = (st[0] + st[1]) + (st[2] + st[3]); ss += __shfl_xor(ss, 16); ss += __shfl_xor(ss, 32);
                const float rstd = __builtin_amdgcn_rsqf(ss * (1.0f / 1024.0f) + RMS_EPS_F) * sc;
                bf16_t* rowp = base + (size_t)row * ld + col0;
                if (mode == 2) {
                    const float nr = -1.4426950408889634f * rstd; f32x4 rr[2], mm[2];
#pragma unroll
                    for (int n = 0; n < 2; ++n)
#pragma unroll
                        for (int e = 0; e < 4; ++e) { const float d0 = 1.0f + __builtin_amdgcn_exp2f(__builtin_fmaf(acc[ai][0][m][n][e], nr, bv[0][n][e]));
                            const float d1 = __builtin_fminf(1.0f + __builtin_amdgcn_exp2f(__builtin_fmaf(acc[ai][1][m][n][e], nr, bv[1][n][e])), 1.2676506002282294e30f);
                            mm[n][e] = __builtin_amdgcn_rcpf(d1); rr[n][e] = d1 * __builtin_amdgcn_rcpf(d0); }
                    bf16_t* gp = G + (size_t)row * 2048 + chan0;
                    u32x4 w; w.x = cvt_pk_bf16(rr[0][0], rr[0][1]); w.y = cvt_pk_bf16(rr[0][2], rr[0][3]); w.z = cvt_pk_bf16(rr[1][0], rr[1][1]); w.w = cvt_pk_bf16(rr[1][2], rr[1][3]);
                    __builtin_nontemporal_store(w, (u32x4*)gp);
                    w.x = cvt_pk_bf16(mm[0][0], mm[0][1]); w.y = cvt_pk_bf16(mm[0][2], mm[0][3]); w.z = cvt_pk_bf16(mm[1][0], mm[1][1]); w.w = cvt_pk_bf16(mm[1][2], mm[1][3]);
                    __builtin_nontemporal_store(w, (u32x4*)(gp + 1024));
                } else
#pragma unroll
                for (int bj = 0; bj < 2; ++bj) { f32x4 v0, v1;
                    v0 = acc[ai][bj][m][0] * rstd; v1 = acc[ai][bj][m][1] * rstd;
                    if (mode == 1) {
#pragma unroll
                        for (int e = 0; e < 4; ++e) { v0[e] = v0[e] * sigmoid_f(v0[e]); v1[e] = v1[e] * sigmoid_f(v1[e]); } }
                    u32x4 w; w.x = cvt_pk_bf16(v0[0], v0[1]); w.y = cvt_pk_bf16(v0[2], v0[3]); w.z = cvt_pk_bf16(v1[0], v1[1]); w.w = cvt_pk_bf16(v1[2], v1[3]);
                    __builtin_nontemporal_store(w, (u32x4*)(rowp + bj * 32)); } }
    }
};
struct EpiMergeMid {
    static constexpr bool PERM = true, AFTER_DRAIN = false, HAS_MID = true;
    bf16_t* MG; const bf16_t* G;
    __device__ __forceinline__ void mid(f32x4 (&acc)[2][2][4][2], const Unit& u, int wr, int wc, int fr, int fq) const {
        const int row0 = u.pm * BM + wr * 64 + fr, col0 = u.pn * BM + wc * 64 + 8 * fq;
#pragma unroll
        for (int ai = 0; ai < 2; ++ai)
#pragma unroll
            for (int m = 0; m < 4; ++m) { const int row = row0 + ai * HALF + m * 16;
#pragma unroll
                for (int bj = 0; bj < 2; ++bj) { const u32x4 a = *(const u32x4*)(G + (size_t)row * 2048 + col0 + bj * 32);
                    f32x4& v0 = acc[ai][bj][m][0]; f32x4& v1 = acc[ai][bj][m][1];
                    v0[0] *= bf_lo(a.x); v0[1] *= bf_hi(a.x); v0[2] *= bf_lo(a.y); v0[3] *= bf_hi(a.y);
                    v1[0] *= bf_lo(a.z); v1[1] *= bf_hi(a.z); v1[2] *= bf_lo(a.w); v1[3] *= bf_hi(a.w); } }
    }
    __device__ __forceinline__ void operator()(const f32x4 (&acc)[2][2][4][2], const Unit& u, int wr, int wc, int fr, int fq) const {
        const int row0 = u.pm * BM + wr * 64 + fr, col0 = u.pn * BM + wc * 64 + 8 * fq;
#pragma unroll
        for (int ai = 0; ai < 2; ++ai)
#pragma unroll
            for (int m = 0; m < 4; ++m) { const int row = row0 + ai * HALF + m * 16;
#pragma unroll
                for (int bj = 0; bj < 2; ++bj) { const int col = col0 + bj * 32;
                    const u32x4 b = *(const u32x4*)(G + (size_t)row * 2048 + 1024 + col);
                    const f32x4 v0 = acc[ai][bj][m][0], v1 = acc[ai][bj][m][1];
                    u32x4 w; w.x = cvt_pk_bf16(v0[0] * bf_lo(b.x), v0[1] * bf_hi(b.x)); w.y = cvt_pk_bf16(v0[2] * bf_lo(b.y), v0[3] * bf_hi(b.y));
                    w.z = cvt_pk_bf16(v1[0] * bf_lo(b.z), v1[1] * bf_hi(b.z)); w.w = cvt_pk_bf16(v1[2] * bf_lo(b.w), v1[3] * bf_hi(b.w));
                    *(u32x4*)(MG + (size_t)row * 1024 + col) = w; } }
    }
};
struct EpiOut {
    static constexpr bool PERM = true, AFTER_DRAIN = false, HAS_MID = false;
    const float* xin; float* xout; bf16_t* XG; const float* gnext; float* ssp; int write_xg;
    __device__ __forceinline__ void operator()(const f32x4 (&acc)[2][2][4][2], const Unit& u, int wr, int wc, int fr, int fq) const {
        const int col0 = u.pn * BM + wc * 64 + 8 * fq;
#pragma unroll
        for (int ai = 0; ai < 2; ++ai)
#pragma unroll
            for (int m = 0; m < 4; ++m) { const int row = u.pm * BM + ai * HALF + wr * 64 + m * 16 + fr; const size_t off = (size_t)row * 1024 + col0; float ss = 0.f;
#pragma unroll
                for (int bj = 0; bj < 2; ++bj) { const int co = bj * 32;
                    const f32x4 v0 = *(const f32x4*)(xin + off + co) + acc[ai][bj][m][0], v1 = *(const f32x4*)(xin + off + co + 4) + acc[ai][bj][m][1];
                    __builtin_nontemporal_store(v0, (f32x4*)(xout + off + co)); __builtin_nontemporal_store(v1, (f32x4*)(xout + off + co + 4));
                    ss += ((v0[0] * v0[0] + v0[1] * v0[1]) + (v0[2] * v0[2] + v0[3] * v0[3])) + ((v1[0] * v1[0] + v1[1] * v1[1]) + (v1[2] * v1[2] + v1[3] * v1[3]));
                    if (write_xg) { const f32x4 g0 = *(const f32x4*)(gnext + col0 + co), g1 = *(const f32x4*)(gnext + col0 + co + 4);
                        u32x4 w; w.x = cvt_pk_bf16(v0[0] * g0[0], v0[1] * g0[1]); w.y = cvt_pk_bf16(v0[2] * g0[2], v0[3] * g0[3]); w.z = cvt_pk_bf16(v1[0] * g1[0], v1[1] * g1[1]); w.w = cvt_pk_bf16(v1[2] * g1[2], v1[3] * g1[3]);
                        *(u32x4*)(XG + off + co) = w; } }
                ss += __shfl_xor(ss, 16); ss += __shfl_xor(ss, 32);
                if (fq == 0) ssp[(size_t)row * 16 + u.pn * 4 + wc] = ss; }
    }
};

struct EpiOutNorm {
    static constexpr bool PERM = false, AFTER_DRAIN = false, HAS_MID = false;
    const float* xin; float* out; const float* fg; float* xbuf; unsigned* cnt; PG8_LAS unsigned char* lx;
    __device__ __forceinline__ void operator()(f32x4 (&acc)[2][2][4][2], const Unit& u, int wr, int wc, int fr, int fq) const {
        PG8_LAS float* P = (PG8_LAS float*)lx;
        PG8_LAS float* S = (PG8_LAS float*)(lx + 4096);
        const int col0 = u.pn * BM + wc * 64 + 4 * fq, wid = wr * 4 + wc, lane = fq * 16 + fr;
#pragma unroll
        for (int ai = 0; ai < 2; ++ai)
#pragma unroll
            for (int m = 0; m < 4; ++m) { const int rl = ai * HALF + wr * 64 + m * 16 + fr; const size_t off = (size_t)(u.pm * BM + rl) * 1024 + col0; float ss = 0.f;
#pragma unroll
                for (int bj = 0; bj < 2; ++bj)
#pragma unroll
                    for (int n = 0; n < 2; ++n) { const f32x4 v = *(const f32x4*)(xin + off + bj * 32 + n * 16) + acc[ai][bj][m][n]; acc[ai][bj][m][n] = v;
                        ss += (v[0] * v[0] + v[1] * v[1]) + (v[2] * v[2] + v[3] * v[3]); }
                ss += __shfl_xor(ss, 16); ss += __shfl_xor(ss, 32);
                if (fq == 0) P[rl * 4 + wc] = ss;
                if (m & 1) asm volatile("" ::: "memory"); }
        asm volatile("s_waitcnt lgkmcnt(0)" ::: "memory"); __builtin_amdgcn_s_barrier(); asm volatile("" ::: "memory");
        const int rowl = wid * 32 + (lane & 31);
        if (lane < 32) { const float ts = (P[rowl * 4 + 0] + P[rowl * 4 + 1]) + (P[rowl * 4 + 2] + P[rowl * 4 + 3]);
            __hip_atomic_store(xbuf + ((size_t)(u.pm * BM + rowl) * 4 + u.pn), ts, __ATOMIC_RELAXED, __HIP_MEMORY_SCOPE_AGENT); }
        asm volatile("s_waitcnt vmcnt(0)" ::: "memory");
        __builtin_amdgcn_s_barrier(); asm volatile("" ::: "memory");
        if (wid == 0) { unsigned spins = 0;
            if (lane == 0) __hip_atomic_fetch_add(cnt + 64 * u.pm, 1u, __ATOMIC_RELAXED, __HIP_MEMORY_SCOPE_AGENT);
            while ((unsigned)__builtin_amdgcn_readfirstlane(__hip_atomic_load(cnt + 64 * u.pm, __ATOMIC_RELAXED, __HIP_MEMORY_SCOPE_AGENT)) < 4u) { __builtin_amdgcn_s_sleep(2); if (++spins > (1u << 22)) break; } }
        asm volatile("s_waitcnt vmcnt(0) lgkmcnt(0)" ::: "memory"); __builtin_amdgcn_s_barrier(); asm volatile("" ::: "memory");
        if (lane < 32) { const float* slot = xbuf + (size_t)(u.pm * BM + rowl) * 4; float q = 0.f;
#pragma unroll
            for (int t = 0; t < 4; ++t) q += __hip_atomic_load(slot + t, __ATOMIC_RELAXED, __HIP_MEMORY_SCOPE_AGENT);
            S[rowl] = __builtin_amdgcn_rsqf(q * (1.0f / 1024.0f) + RMS_EPS_F); }
        asm volatile("s_waitcnt lgkmcnt(0)" ::: "memory"); __builtin_amdgcn_s_barrier(); asm volatile("" ::: "memory");
        f32x4 gv[2][2];
#pragma unroll
        for (int bj = 0; bj < 2; ++bj)
#pragma unroll
            for (int n = 0; n < 2; ++n) gv[bj][n] = *(const f32x4*)(fg + col0 + bj * 32 + n * 16);
#pragma unroll
        for (int ai = 0; ai < 2; ++ai)
#pragma unroll
            for (int m = 0; m < 4; ++m) { const int rl = ai * HALF + wr * 64 + m * 16 + fr; const float rs = S[rl]; const size_t off = (size_t)(u.pm * BM + rl) * 1024 + col0;
#pragma unroll
                for (int bj = 0; bj < 2; ++bj)
#pragma unroll
                    for (int n = 0; n < 2; ++n) __builtin_nontemporal_store(acc[ai][bj][m][n] * rs * gv[bj][n], (f32x4*)(out + off + bj * 32 + n * 16)); }
    }
};
template <class Epi, class Sched, bool ALIGN_EPI = false, bool SP2 = false>
__device__ __forceinline__ void gemm_phase(PG8_LAS unsigned char* lds, const Gemm g_in, const Sched& S, const Epi& E) {
    Gemm g = g_in; asm volatile("" : "+s"(g.A), "+s"(g.Bt));
    int tid_ = threadIdx.x; asm volatile("" : "+v"(tid_));
    const int tid = tid_, wid = __builtin_amdgcn_readfirstlane(tid >> 6), lane = tid & 63, wr = wid >> 2, wc = wid & 3, fr = lane & 15, fq = lane >> 4;
    const int K = g.K, nt = K / BK;
    unsigned voffA[2], voffB[2];
#pragma unroll
    for (int i = 0; i < 2; ++i) { int R, C; stage_rc(tid * 16 + i * 8192, R, C); const int Rb = 2 * (R & ~31) + (Epi::PERM ? perm32(R & 31) : (R & 31));
        voffA[i] = (unsigned)(R * g.lda + C) * 2u; voffB[i] = (unsigned)(Rb * g.ldb + C) * 2u; }
    const size_t kstep = (size_t)(BK * 2);
    const size_t hstepA = (size_t)HALF * g.lda * 2, hstepB = (size_t)32 * g.ldb * 2;
    const size_t tstepA = 2 * hstepA, tstepB = (size_t)BM * g.ldb * 2;
    const unsigned ldsw = (unsigned)wid * 1024u;
    const int aoff = lds_byte(wr * 64 + fr, fq * 8), boff = lds_byte(wc * 32 + fr, fq * 8);
#define PG8_SA(b, h) (((b) * 2 + (h)) * HTB)
#define PG8_SB(b, h) ((4 + (b) * 2 + (h)) * HTB)
#define PG8_STAGE(bufoff, gbase, voff) do { _Pragma("unroll") for (int _i = 0; _i < 2; ++_i) \
        __builtin_amdgcn_global_load_lds((const unsigned*)((const char*)(gbase) + (voff)[_i]), (PG8_LAS unsigned*)(lds + (bufoff) + ldsw + _i * 8192), 16, 0, 0); } while (0)
#define PG8_LDA(dst, b, h) do { _Pragma("unroll") for (int m = 0; m < 4; ++m) _Pragma("unroll") for (int k = 0; k < 2; ++k) dst[m][k] = *(const PG8_LAS bf16x8*)(lds + PG8_SA(b, h) + aoff + m * 2048 + k * 1024); } while (0)
#define PG8_LDB(dst, b, h) do { _Pragma("unroll") for (int n = 0; n < 2; ++n) _Pragma("unroll") for (int k = 0; k < 2; ++k) dst[n][k] = *(const PG8_LAS bf16x8*)(lds + PG8_SB(b, h) + boff + n * 2048 + k * 1024); } while (0)
#define PG8_MMA(ai, bj, At, Bt) do { __builtin_amdgcn_s_setprio(1); _Pragma("unroll") for (int m = 0; m < 4; ++m) _Pragma("unroll") for (int n = 0; n < 2; ++n) _Pragma("unroll") for (int k = 0; k < 2; ++k) \
        acc[ai][bj][m][n] = __builtin_amdgcn_mfma_f32_16x16x32_bf16(Bt[n][k], At[m][k], acc[ai][bj][m][n], 0, 0, 0); __builtin_amdgcn_s_setprio(0); } while (0)
#define PG8_WAIT_V(n) asm volatile("s_waitcnt vmcnt(" #n ")" ::: "memory")
#define PG8_WAIT_L(n) asm volatile("s_waitcnt lgkmcnt(" #n ")" ::: "memory")
#define PG8_BAR __builtin_amdgcn_s_barrier()
#define PG8_SCHED __builtin_amdgcn_sched_barrier(0)
    Unit cur, nxt; int ui = 0;
    if (!S.next(0, cur)) return;
    f32x4 acc[2][2][4][2];
#pragma unroll
    for (int a = 0; a < 2; ++a)
#pragma unroll
        for (int b = 0; b < 2; ++b)
#pragma unroll
            for (int m = 0; m < 4; ++m)
#pragma unroll
                for (int n = 0; n < 2; ++n) acc[a][b][m][n] = (f32x4){0.f, 0.f, 0.f, 0.f};
    bf16x8 At[4][2], B0[2][2], B1[2][2];
    const char* cA = (const char*)g.A + (size_t)cur.pm * tstepA; const char* cB = (const char*)g.Bt + (size_t)cur.pn * tstepB;
    S.a_ready(cur);
    if constexpr (SP2) {
        PG8_STAGE(PG8_SB(0, 0), cB, voffB); PG8_STAGE(PG8_SB(0, 1), cB + hstepB, voffB); PG8_STAGE(PG8_SA(0, 0), cA, voffA); PG8_STAGE(PG8_SA(0, 1), cA + hstepA, voffA);
        if (wr == 1) PG8_BAR;
        PG8_WAIT_V(2); PG8_BAR;
        PG8_STAGE(PG8_SB(1, 0), cB + kstep, voffB); PG8_STAGE(PG8_SA(1, 0), cA + kstep, voffA); PG8_STAGE(PG8_SB(1, 1), cB + hstepB + kstep, voffB);
        PG8_WAIT_V(6); PG8_BAR;
    } else {
        PG8_STAGE(PG8_SB(0, 0), cB, voffB); PG8_STAGE(PG8_SA(0, 0), cA, voffA); PG8_STAGE(PG8_SB(0, 1), cB + hstepB, voffB); PG8_STAGE(PG8_SA(0, 1), cA + hstepA, voffA);
        if (wr == 1) PG8_BAR;
        PG8_WAIT_V(4); PG8_BAR;
        PG8_STAGE(PG8_SB(1, 0), cB + kstep, voffB); PG8_STAGE(PG8_SA(1, 0), cA + kstep, voffA); PG8_STAGE(PG8_SB(1, 1), cB + hstepB + kstep, voffB);
        PG8_WAIT_V(6); PG8_BAR;
    }
    for (;;) {
        const bool has_next = S.next(ui + 1, nxt);
        const char* nA = has_next ? (const char*)g.A + (size_t)nxt.pm * tstepA : cA; const char* nB = has_next ? (const char*)g.Bt + (size_t)nxt.pn * tstepB : cB;
        for (int t = 0; t < nt; t += 2) {
            if constexpr (Epi::HAS_MID) { if (t == (nt >> 1)) { int fr_ = fr, fq_ = fq; asm volatile("" : "+v"(fr_), "+v"(fq_)); E.mid(acc, cur, wr, wc, fr_, fq_); } }
            const bool last = (t == nt - 2);
            const char* a1 = cA + (size_t)(t + 1) * kstep;
            const char* a2 = last ? nA : cA + (size_t)(t + 2) * kstep; const char* b2 = last ? nB : cB + (size_t)(t + 2) * kstep;
            const char* a3 = a2 + kstep; const char* b3 = b2 + kstep;
            if (last && has_next) S.a_ready(nxt);
            if constexpr (SP2) {
            PG8_LDB(B0, 0, 0); PG8_LDB(B1, 0, 1); PG8_SCHED; PG8_LDA(At, 0, 0); PG8_STAGE(PG8_SA(1, 1), a1 + hstepA, voffA);
            PG8_WAIT_V(8); PG8_WAIT_L(0); PG8_BAR; PG8_MMA(0, 0, At, B0); PG8_MMA(0, 1, At, B1); PG8_BAR; PG8_SCHED;
            PG8_LDA(At, 0, 1); PG8_STAGE(PG8_SB(0, 0), b2, voffB); PG8_STAGE(PG8_SB(0, 1), b2 + hstepB, voffB); PG8_STAGE(PG8_SA(0, 0), a2, voffA);
            PG8_WAIT_V(8); PG8_WAIT_L(0); PG8_BAR; PG8_MMA(1, 0, At, B0); PG8_MMA(1, 1, At, B1); PG8_BAR; PG8_SCHED;
            PG8_LDB(B0, 1, 0); PG8_LDB(B1, 1, 1); PG8_SCHED; PG8_LDA(At, 1, 0); PG8_STAGE(PG8_SA(0, 1), a2 + hstepA, voffA);
            PG8_WAIT_V(8); PG8_WAIT_L(0); PG8_BAR; PG8_MMA(0, 0, At, B0); PG8_MMA(0, 1, At, B1); PG8_BAR; PG8_SCHED;
            PG8_LDA(At, 1, 1); PG8_STAGE(PG8_SB(1, 0), b3, voffB); PG8_STAGE(PG8_SB(1, 1), b3 + hstepB, voffB); PG8_STAGE(PG8_SA(1, 0), a3, voffA);
            PG8_WAIT_V(8); PG8_WAIT_L(0); PG8_BAR; PG8_MMA(1, 0, At, B0); PG8_MMA(1, 1, At, B1); PG8_BAR; PG8_SCHED;
            } else {
            PG8_LDB(B0, 0, 0); PG8_SCHED; PG8_LDA(At, 0, 0); PG8_STAGE(PG8_SA(1, 1), a1 + hstepA, voffA);
            PG8_WAIT_L(8); PG8_BAR; PG8_WAIT_L(0); PG8_MMA(0, 0, At, B0); PG8_BAR; PG8_SCHED;
            PG8_LDB(B1, 0, 1); PG8_STAGE(PG8_SB(0, 0), b2, voffB);
            PG8_BAR; PG8_WAIT_L(0); PG8_MMA(0, 1, At, B1); PG8_BAR;
            PG8_LDA(At, 0, 1); PG8_STAGE(PG8_SA(0, 0), a2, voffA);
            PG8_BAR; PG8_WAIT_L(0); PG8_MMA(1, 0, At, B0); PG8_BAR; PG8_SCHED;
            PG8_STAGE(PG8_SB(0, 1), b2 + hstepB, voffB);
            PG8_WAIT_V(6); PG8_BAR; PG8_MMA(1, 1, At, B1); PG8_BAR;
            PG8_LDB(B0, 1, 0); PG8_SCHED; PG8_LDA(At, 1, 0); PG8_STAGE(PG8_SA(0, 1), a2 + hstepA, voffA);
            PG8_WAIT_L(8); PG8_BAR; PG8_WAIT_L(0); PG8_MMA(0, 0, At, B0); PG8_BAR; PG8_SCHED;
            PG8_LDB(B1, 1, 1); PG8_STAGE(PG8_SB(1, 0), b3, voffB);
            PG8_BAR; PG8_WAIT_L(0); PG8_MMA(0, 1, At, B1); PG8_BAR;
            PG8_LDA(At, 1, 1); PG8_STAGE(PG8_SA(1, 0), a3, voffA);
            PG8_BAR; PG8_WAIT_L(0); PG8_MMA(1, 0, At, B0); PG8_BAR; PG8_SCHED;
            PG8_STAGE(PG8_SB(1, 1), b3 + hstepB, voffB);
            PG8_WAIT_V(6); PG8_BAR; PG8_MMA(1, 1, At, B1); PG8_BAR;
            }
        }
        if constexpr (ALIGN_EPI) { if (wr == 0) PG8_BAR; }
        if constexpr (!Epi::AFTER_DRAIN) { int fr_ = fr, fq_ = fq; asm volatile("" : "+v"(fr_), "+v"(fq_));   E(acc, cur, wr, wc, fr_, fq_); S.done(cur); }
        if (!has_next) break;
#pragma unroll
        for (int a = 0; a < 2; ++a)
#pragma unroll
            for (int b = 0; b < 2; ++b)
#pragma unroll
                for (int m = 0; m < 4; ++m)
#pragma unroll
                    for (int n = 0; n < 2; ++n) acc[a][b][m][n] = (f32x4){0.f, 0.f, 0.f, 0.f};
        cur = nxt; cA = nA; cB = nB; ++ui;
        if constexpr (ALIGN_EPI) { if (wr == 1) PG8_BAR; }
    }
    PG8_WAIT_V(0);
    if constexpr (!ALIGN_EPI) { if (wr == 0) PG8_BAR; }
    PG8_BAR;
    if constexpr (Epi::AFTER_DRAIN) { E.fused(acc, cur, wr, wc, fr, fq, lds, wid, lane); S.done(cur); }
#undef PG8_SA
#undef PG8_SB
#undef PG8_STAGE
#undef PG8_LDA
#undef PG8_LDB
#undef PG8_MMA
#undef PG8_WAIT_V
#undef PG8_WAIT_L
#undef PG8_BAR
#undef PG8_SCHED
}
}
#define LAS __attribute__((address_space(3)))
typedef unsigned short bf16;
typedef unsigned v4u __attribute__((ext_vector_type(4)));
typedef unsigned v2u __attribute__((ext_vector_type(2)));
typedef float f32x4 __attribute__((ext_vector_type(4)));
typedef float f32x16 __attribute__((ext_vector_type(16)));
typedef short bf16x8 __attribute__((ext_vector_type(8)));
typedef short s16x4 __attribute__((ext_vector_type(4)));
constexpr int NB = 4, SEQ = 8192, DM = 1024, T = NB * SEQ, NIN = 5120, NH = 8;
constexpr size_t MiB = 1u << 20;
constexpr size_t WS_BAR = 0, WS_PCNT = 16384, BAR_ZERO_BYTES = 65536;
constexpr size_t WS_XBUF = 3 * MiB;
constexpr size_t WS_SSP = 1 * MiB;
constexpr size_t WS_W = 4 * MiB, W_LAYER = 14 * MiB;
constexpr size_t WS_XG = 32 * MiB;
constexpr size_t WS_VP = 96 * MiB, WS_ZP = 128 * MiB, WS_Q = 160 * MiB, WS_K = 192 * MiB, WS_V = 224 * MiB, WS_ZA = 256 * MiB;
constexpr size_t WS_G = 288 * MiB;
constexpr size_t WS_Y = 416 * MiB;
constexpr size_t WS_MG = WS_Q;
constexpr size_t WS_END = 480 * MiB;
constexpr int LDS_BYTES = 147456;
constexpr int LDS_XTAB = 131072;
constexpr int LDS_MISC = 139264;
constexpr int NWAVES = 8, NTHREADS = 512;
constexpr int STAGGER_P1 = 0;
constexpr int REP_P0 = 1, REP_P1 = 1, REP_P2 = 1, REP_P3A = 1, REP_SYNC = 1, REP_P3B = 1, REP_FIN = 1, REP_ATT = 1, REP_POOL = 1;

__device__ __forceinline__ unsigned f2bf(float f) { unsigned u = __builtin_bit_cast(unsigned, f); return (u + 0x7fffu + ((u >> 16) & 1u)) >> 16; }
__device__ __forceinline__ unsigned pk2(float lo, float hi) { return f2bf(lo) | (f2bf(hi) << 16); }
typedef float f32x2_t __attribute__((ext_vector_type(2))); typedef __bf16 bf16x2_t __attribute__((ext_vector_type(2)));
__device__ __forceinline__ unsigned cvtpk(float lo, float hi) { f32x2_t v = {lo, hi}; bf16x2_t b = __builtin_convertvector(v, bf16x2_t); return __builtin_bit_cast(unsigned, b); }
__device__ __forceinline__ float bflo(unsigned u) { return __uint_as_float(u << 16); }
__device__ __forceinline__ float bfhi(unsigned u) { return __uint_as_float(u & 0xffff0000u); }
__device__ __forceinline__ float wave_sum(float v) {
#pragma unroll
    for (int o = 1; o < 64; o <<= 1) v += __shfl_xor(v, o);
    return v;
}
#define LDS_WAIT() asm volatile("s_waitcnt lgkmcnt(0)" ::: "memory")

__device__ __forceinline__ void tr_item(const float* W, int ldw, bf16* WT, int ldt, int k0, int n0, int trow0, int tcol0, LAS float* scr, int lane) {
#pragma unroll 8
    for (int i = 0; i < 32; ++i) { const int kk = 2 * i + (lane >> 5); scr[kk * 33 + (lane & 31)] = W[(size_t)(k0 + kk) * ldw + n0 + (lane & 31)]; }
    LDS_WAIT();
    const int c = lane & 7;
#pragma unroll
    for (int j = 0; j < 4; ++j) { const int n = (lane >> 3) + 8 * j; const LAS float* s = scr + (8 * c) * 33 + n;
        v4u o; o.x = pk2(s[0 * 33], s[1 * 33]); o.y = pk2(s[2 * 33], s[3 * 33]); o.z = pk2(s[4 * 33], s[5 * 33]); o.w = pk2(s[6 * 33], s[7 * 33]);
        *(v4u*)(WT + (size_t)(trow0 + n) * ldt + tcol0 + 8 * c) = o; }
    LDS_WAIT();
}

#define RLX_AGENT __ATOMIC_RELAXED, __HIP_MEMORY_SCOPE_AGENT
#define XB_TMO      128
#define XB_XCNT(j)  (256  + 64 * (j))
#define XB_XSUB(j)  (1280 + 64 * (j))
#define XB_XGEN(j)  (2304 + 64 * (j))
#define XB_TOP      3328
#define XB_TOPGEN   3392
#define XCD_BAR_WORDS 3456
#define XB_SPIN_CAP (1u << 18)

__device__ __forceinline__ unsigned xb_ld(unsigned* p)              { return __hip_atomic_load(p, __ATOMIC_RELAXED, __HIP_MEMORY_SCOPE_AGENT); }
__device__ __forceinline__ unsigned xb_add(unsigned* p, unsigned v) { return __hip_atomic_fetch_add(p, v, __ATOMIC_RELAXED, __HIP_MEMORY_SCOPE_AGENT); }
__device__ __forceinline__ unsigned xb_xcc_id() { return (unsigned)__builtin_amdgcn_s_getreg((3 << 11) | 20) & 0xFu; }
#define XB_SPIN(cond, bar) do { unsigned _sp = 0; while (cond) { __builtin_amdgcn_s_sleep(1); \
    if ((++_sp & 255u) == 0u) { if (xb_ld(&(bar)[XB_TMO])) break; if (_sp > XB_SPIN_CAP) { atomicAdd(&(bar)[XB_TMO], 1u); break; } } } } while (0)

struct XcdBarrier {
    unsigned* bar; unsigned x;
    volatile LAS unsigned* st;
};

__device__ __forceinline__ XcdBarrier xcd_barrier_post(unsigned* bar, volatile LAS unsigned* st) {
    XcdBarrier b; b.bar = bar; b.x = xb_xcc_id(); b.st = st;
    if (threadIdx.x == 0) (void)xb_add(&bar[XB_XCNT(b.x)], 1u);
    return b;
}
__device__ __forceinline__ void xcd_barrier_complete(unsigned* bar, unsigned x, unsigned& nloc, unsigned& nx) {
    const unsigned G = gridDim.x * gridDim.y * gridDim.z;
    unsigned sum, cnt, mine, sp = 0u;
    for (;;) {
        sum = 0u; cnt = 0u; mine = 0u;
#pragma unroll
        for (unsigned j = 0; j < 16; ++j) { const unsigned c = xb_ld(&bar[XB_XCNT(j)]); sum += c; cnt += (c > 0u) ? 1u : 0u; mine = (j == x) ? c : mine; }
        if (sum == G) break;
        __builtin_amdgcn_s_sleep(1);
        if ((++sp & 255u) == 0u) { if (xb_ld(&bar[XB_TMO])) break; if (sp > XB_SPIN_CAP) { atomicAdd(&bar[XB_TMO], 1u); break; } }
    }
    nloc = mine > 0u ? mine : 1u; nx = cnt > 0u ? cnt : 1u;
}

__device__ __forceinline__ void xcd_barrier(const XcdBarrier& b) {
    asm volatile("s_waitcnt vmcnt(0)" ::: "memory");
    __syncthreads();
    if (threadIdx.x == 0) {
        unsigned* bar = b.bar;
        __builtin_amdgcn_s_waitcnt(0);
        unsigned nloc = b.st[0], nx = b.st[1];
        if (nloc == 0u) { xcd_barrier_complete(bar, b.x, nloc, nx); b.st[0] = nloc; b.st[1] = nx; }
        const unsigned old = xb_add(&bar[XB_XSUB(b.x)], 1u);
        const unsigned gen = old / nloc;
        if (old + 1u == (gen + 1u) * nloc) {
            __builtin_amdgcn_fence(__ATOMIC_RELEASE, "agent");
            asm volatile("s_waitcnt vmcnt(0)" ::: "memory");
            const unsigned og = xb_add(&bar[XB_TOP], 1u);
            const unsigned tg = og / nx;
            if (og + 1u == (tg + 1u) * nx) xb_add(&bar[XB_TOPGEN], 1u);
            else XB_SPIN(xb_ld(&bar[XB_TOPGEN]) == tg, bar);
            __builtin_amdgcn_fence(__ATOMIC_ACQUIRE, "agent");
            xb_add(&bar[XB_XGEN(b.x)], 1u);
            asm volatile("s_waitcnt vmcnt(0)" ::: "memory");
        } else {
            XB_SPIN(xb_ld(&bar[XB_XGEN(b.x)]) == gen, bar);
            __builtin_amdgcn_fence(__ATOMIC_ACQUIRE, "agent");
            asm volatile("s_waitcnt vmcnt(0)" ::: "memory");
        }
    }
    __syncthreads();
}
constexpr int VPITCH = 144;
constexpr float SB_EXIT = 1.17549435e-38f;
__device__ __forceinline__ int crow(int r, int hi) { return (r & 3) + 8 * (r >> 2) + 4 * hi; }
__device__ __forceinline__ s16x4 vtr(const LAS unsigned char* p) { typedef short v4i16_t __attribute__((ext_vector_type(4)));
    return __builtin_bit_cast(s16x4, __builtin_amdgcn_ds_read_tr16_b64_v4i16((LAS v4i16_t*)p)); }
constexpr int KOFF = 4608, OPITCH = 272;
__device__ __forceinline__ bool attn_tile(v4u (&kc)[4], v4u (&vc)[4], v4u (&kl)[4], v4u (&vl2)[4], const bf16*& kp, const bf16*& vp, int kt, int qt,
                                          const bf16x8 (&qf)[4], f32x16& o0, f32x16& o1, float& pc, LAS unsigned char* vl, unsigned vwb, unsigned frb, unsigned trb, int j, int hi) {
    {
        const int step = (kt > 1) ? 32 * 512 : 0; kp -= step; vp -= step;
#pragma unroll
        for (int i = 0; i < 4; ++i) kl[i] = *(const v4u*)(kp + (size_t)i * 8 * 512);
#pragma unroll
        for (int i = 0; i < 4; ++i) vl2[i] = *(const v4u*)(vp + (size_t)i * 8 * 512);
    }
#pragma unroll
    for (int i = 0; i < 4; ++i) { *(LAS v4u*)(vl + KOFF + vwb + i * 8 * VPITCH) = kc[i]; *(LAS v4u*)(vl + vwb + i * 8 * VPITCH) = vc[i]; }
    asm volatile("" ::: "memory");
    f32x16 sc;
#pragma unroll
    for (int r = 0; r < 16; ++r) sc[r] = 0.f;
#pragma unroll
    for (int s = 0; s < 4; ++s) { const bf16x8 kf = *(const LAS bf16x8*)(vl + KOFF + frb + 32 * s);
        sc = __builtin_amdgcn_mfma_f32_32x32x16_bf16(kf, qf[s], sc, 0, 0, 0); }
    const bool diag = (kt == qt);
    float be[16], om[16];
#pragma unroll
    for (int r = 0; r < 16; ++r) { const float bb = __builtin_amdgcn_rcpf(1.0f + __builtin_amdgcn_exp2f(-sc[r]));
        be[r] = bb; om[r] = 1.0f - bb; }
    if (diag) {
#pragma unroll
        for (int r = 0; r < 16; ++r) if (crow(r, hi) >= j) { be[r] = 0.f; om[r] = 1.0f; } }
    float Rp[4], Tt[4];
#pragma unroll
    for (int a = 0; a < 4; ++a) { const float R = (om[4 * a] * om[4 * a + 1]) * (om[4 * a + 2] * om[4 * a + 3]); Rp[a] = __shfl_xor(R, 32); Tt[a] = R * Rp[a]; }
    float suf = pc; float w[16];
#pragma unroll
    for (int a = 3; a >= 0; --a) { float c = (hi == 0) ? suf * Rp[a] : suf;
        w[4 * a + 3] = be[4 * a + 3] * c; c *= om[4 * a + 3];
        w[4 * a + 2] = be[4 * a + 2] * c; c *= om[4 * a + 2];
        w[4 * a + 1] = be[4 * a + 1] * c; c *= om[4 * a + 1];
        w[4 * a] = be[4 * a] * c;
        suf *= Tt[a]; }
    pc = suf;
    bf16x8 pf[2];
#pragma unroll
    for (int s = 0; s < 2; ++s) { v4u p; p.x = cvtpk(w[8 * s], w[8 * s + 1]); p.y = cvtpk(w[8 * s + 2], w[8 * s + 3]); p.z = cvtpk(w[8 * s + 4], w[8 * s + 5]); p.w = cvtpk(w[8 * s + 6], w[8 * s + 7]);
        pf[s] = __builtin_bit_cast(bf16x8, p); }
#pragma unroll
    for (int s = 0; s < 2; ++s) {
        { const s16x4 lo = vtr(vl + trb + (16 * s) * VPITCH), hh = vtr(vl + trb + (16 * s + 8) * VPITCH);
          const bf16x8 vf = (bf16x8){lo[0], lo[1], lo[2], lo[3], hh[0], hh[1], hh[2], hh[3]};
          o0 = __builtin_amdgcn_mfma_f32_32x32x16_bf16(vf, pf[s], o0, 0, 0, 0); }
        { const s16x4 lo = vtr(vl + trb + (16 * s) * VPITCH + 64), hh = vtr(vl + trb + (16 * s + 8) * VPITCH + 64);
          const bf16x8 vf = (bf16x8){lo[0], lo[1], lo[2], lo[3], hh[0], hh[1], hh[2], hh[3]};
          o1 = __builtin_amdgcn_mfma_f32_32x32x16_bf16(vf, pf[s], o1, 0, 0, 0); }
    }
    asm volatile("" ::: "memory");
    return kt == 0 || __ballot(pc >= SB_EXIT) == 0ull;
}
__device__ __forceinline__ void attn_unit(const bf16* __restrict__ Q, const bf16* __restrict__ K, const bf16* __restrict__ V, const bf16* __restrict__ ZA, bf16* __restrict__ Y,
                                          int b, int h, int qt, LAS unsigned char* vl, int lane) {
    const int j = lane & 31, hi = lane >> 5;
    const size_t row0 = (size_t)b * SEQ + (size_t)qt * 32;
    const int lr = lane >> 3, lc = lane & 7;
    const unsigned vwb = (unsigned)(lr * VPITCH + lc * 16);
    const unsigned frb = (unsigned)(j * VPITCH + 16 * hi);
    const size_t goff = (row0 + lr) * 512 + h * 64 + lc * 8;
    const bf16* kp = K + goff; const bf16* vp = V + goff;
    v4u ka[4], va[4], kb[4], vb[4], kc[4], vc[4];
    {   v4u qr[4];
#pragma unroll
        for (int i = 0; i < 4; ++i) qr[i] = *(const v4u*)(Q + goff + (size_t)i * 8 * 512);
#pragma unroll
        for (int i = 0; i < 4; ++i) ka[i] = *(const v4u*)(kp + (size_t)i * 8 * 512);
#pragma unroll
        for (int i = 0; i < 4; ++i) va[i] = *(const v4u*)(vp + (size_t)i * 8 * 512);
        {   const int step = (qt > 0) ? 32 * 512 : 0; kp -= step; vp -= step;
#pragma unroll
            for (int i = 0; i < 4; ++i) kb[i] = *(const v4u*)(kp + (size_t)i * 8 * 512);
#pragma unroll
            for (int i = 0; i < 4; ++i) vb[i] = *(const v4u*)(vp + (size_t)i * 8 * 512); }
#pragma unroll
        for (int i = 0; i < 4; ++i) *(LAS v4u*)(vl + KOFF + vwb + i * 8 * VPITCH) = qr[i]; }
    asm volatile("" ::: "memory");
    bf16x8 qf[4];
#pragma unroll
    for (int s = 0; s < 4; ++s) qf[s] = *(const LAS bf16x8*)(vl + KOFF + frb + 32 * s);
    asm volatile("" ::: "memory");
    f32x16 o0, o1;
#pragma unroll
    for (int r = 0; r < 16; ++r) { o0[r] = 0.f; o1[r] = 0.f; }
    float pc = 1.0f;
    const int blk = (lane >> 4) & 1, q4 = (lane & 15) >> 2, p4 = lane & 3;
    const unsigned trb = (unsigned)((4 * hi + q4) * VPITCH + (16 * blk + 4 * p4) * 2);
    for (int kt = qt;;) {
        if (attn_tile(ka, va, kc, vc, kp, vp, kt, qt, qf, o0, o1, pc, vl, vwb, frb, trb, j, hi)) break; --kt;
        if (attn_tile(kb, vb, ka, va, kp, vp, kt, qt, qf, o0, o1, pc, vl, vwb, frb, trb, j, hi)) break; --kt;
        if (attn_tile(kc, vc, kb, vb, kp, vp, kt, qt, qf, o0, o1, pc, vl, vwb, frb, trb, j, hi)) break; --kt;
    }
    v4u zz[4];
#pragma unroll
    for (int i = 0; i < 4; ++i) zz[i] = *(const v4u*)(ZA + goff + (size_t)i * 8 * 512);
#pragma unroll
    for (int a = 0; a < 4; ++a) { const int d0 = 8 * a + 4 * hi;
        *(LAS f32x4*)(vl + j * OPITCH + d0 * 4) = (f32x4){o0[4 * a], o0[4 * a + 1], o0[4 * a + 2], o0[4 * a + 3]};
        *(LAS f32x4*)(vl + j * OPITCH + (32 + d0) * 4) = (f32x4){o1[4 * a], o1[4 * a + 1], o1[4 * a + 2], o1[4 * a + 3]}; }
    asm volatile("" ::: "memory");
#pragma unroll
    for (int i = 0; i < 4; ++i) { const int r = lr + 8 * i;
        const f32x4 a0 = *(const LAS f32x4*)(vl + r * OPITCH + lc * 32), a1 = *(const LAS f32x4*)(vl + r * OPITCH + lc * 32 + 16);
        v4u o; o.x = cvtpk(a0[0] * bflo(zz[i].x), a0[1] * bfhi(zz[i].x)); o.y = cvtpk(a0[2] * bflo(zz[i].y), a0[3] * bfhi(zz[i].y));
        o.z = cvtpk(a1[0] * bflo(zz[i].z), a1[1] * bfhi(zz[i].z)); o.w = cvtpk(a1[2] * bflo(zz[i].w), a1[3] * bfhi(zz[i].w));
        *(v4u*)(Y + (row0 + r) * 1024 + 512 + h * 64 + lc * 8) = o; }
    asm volatile("" ::: "memory");
}

__device__ __forceinline__ void unpack8(const v4u q, float (&f)[8]) { f[0] = bflo(q.x); f[1] = bfhi(q.x); f[2] = bflo(q.y); f[3] = bfhi(q.y); f[4] = bflo(q.z); f[5] = bfhi(q.z); f[6] = bflo(q.w); f[7] = bfhi(q.w); }
template <int W> __device__ __forceinline__ void pool_wave_task(const bf16* __restrict__ VP, const bf16* __restrict__ ZP, bf16* __restrict__ Y, int g, int tblk, int lane) {
    const int t0 = tblk * 32 + (lane >> 4) * 8, pos0 = t0 & (SEQ - 1), ch = g * 128 + (lane & 15) * 8;
    const bf16* vp = VP + (size_t)t0 * 512 + ch; const bf16* zp = ZP + (size_t)t0 * 512 + ch; bf16* yp = Y + (size_t)t0 * 1024 + ch;
    v4u hv[W + 7], zv[8];
#pragma unroll
    for (int i = 0; i < W + 7; ++i) { const int off = i - (W - 1); hv[i] = (pos0 + off >= 0) ? *(const v4u*)(vp + (ptrdiff_t)off * 512) : (v4u){0u, 0u, 0u, 0u}; }
#pragma unroll
    for (int t = 0; t < 8; ++t) zv[t] = *(const v4u*)(zp + (size_t)t * 512);
    float s[8];
#pragma unroll
    for (int e = 0; e < 8; ++e) s[e] = 0.f;
#pragma unroll
    for (int i = 0; i < W - 1; ++i) { float f[8]; unpack8(hv[i], f);
#pragma unroll
        for (int e = 0; e < 8; ++e) s[e] += f[e]; }
#pragma unroll
    for (int t = 0; t < 8; ++t) { float v[8], z[8], y[8]; unpack8(hv[W - 1 + t], v); unpack8(zv[t], z);
        const int cnt = (pos0 + t + 1 < W) ? pos0 + t + 1 : W; const float inv = __builtin_amdgcn_rcpf((float)cnt);
#pragma unroll
        for (int e = 0; e < 8; ++e) { s[e] += v[e]; y[e] = (s[e] * inv - v[e]) * z[e]; }
        v4u o; o.x = cvtpk(y[0], y[1]); o.y = cvtpk(y[2], y[3]); o.z = cvtpk(y[4], y[5]); o.w = cvtpk(y[6], y[7]);
        *(v4u*)(yp + (size_t)t * 1024) = o;
        float f[8]; unpack8(hv[t], f);
#pragma unroll
        for (int e = 0; e < 8; ++e) s[e] -= f[e]; }
}

struct Args { const float* in[10]; float* out; unsigned char* ws; };
__global__ void __launch_bounds__(NTHREADS, 2) fwd_megakernel(Args args) {
    extern __shared__ __attribute__((aligned(16))) unsigned char lds_raw[];
    LAS unsigned char* lds = (LAS unsigned char*)lds_raw;
    const int tid = threadIdx.x, lane = tid & 63, wave = __builtin_amdgcn_readfirstlane(tid >> 6);
    const int G = gridDim.x, bx = blockIdx.x, vcu = (G % 8 == 0) ? (bx % 8) * (G / 8) + bx / 8 : bx;
    const int gw = vcu * NWAVES + wave, NGW = G * NWAVES;
    volatile LAS unsigned* MISC = (volatile LAS unsigned*)(lds + LDS_MISC);
    if (tid < 4) MISC[tid] = 0u;
    __syncthreads();
    (void)xcd_barrier_post((unsigned*)(args.ws + WS_BAR), MISC);
#define GRID_BAR() do { XcdBarrier b_; b_.bar = (unsigned*)(args.ws + WS_BAR); b_.x = xb_xcc_id(); b_.st = (volatile LAS unsigned*)(lds + LDS_MISC); xcd_barrier(b_); } while (0)
    const float* x = args.in[0]; const float* norm_g = args.in[1]; const float* w_in = args.in[2]; const float* b_gate = args.in[3]; const float* pool_w = args.in[4];
    const float* pool_scale = args.in[5]; const float* w_pool_up = args.in[6]; const float* w_attn_up = args.in[7]; const float* w_out = args.in[8]; const float* final_g = args.in[9];
    float* out = args.out; unsigned char* ws = args.ws;
    float* SSP = (float*)(ws + WS_SSP);
    bf16* XG = (bf16*)(ws + WS_XG); bf16* VP = (bf16*)(ws + WS_VP); bf16* ZP = (bf16*)(ws + WS_ZP); bf16* Qb = (bf16*)(ws + WS_Q); bf16* Kb = (bf16*)(ws + WS_K);
    bf16* Vb = (bf16*)(ws + WS_V); bf16* ZA = (bf16*)(ws + WS_ZA); bf16* Gt = (bf16*)(ws + WS_G); bf16* Yb = (bf16*)(ws + WS_Y); bf16* MG = (bf16*)(ws + WS_MG);

#pragma nounroll
    for (int rep = 0; rep < REP_P0; ++rep) {
        LAS float* PW = (LAS float*)lds; LAS float* WI = (LAS float*)(lds + 65536);
        for (int it = vcu; it < 256; it += G) {
            const int l = it >> 7, g = (it >> 5) & 3, k0 = (it & 31) * 32;
            const float* pw = pool_w + ((size_t)l * 4 + g) * 16384; const float* wi = w_in + (size_t)l * DM * NIN + (size_t)k0 * NIN + g * 128;
            __syncthreads();
#pragma unroll 4
            for (int i = 0; i < 32; ++i) PW[tid + 512 * i] = pw[tid + 512 * i];
#pragma unroll
            for (int i = 0; i < 8; ++i) { const int idx = tid + 512 * i; WI[idx] = wi[(size_t)(idx >> 7) * NIN + (idx & 127)]; }
            __syncthreads();
            const int d = tid & 127, kq = tid >> 7; float acc[8];
#pragma unroll
            for (int e = 0; e < 8; ++e) acc[e] = 0.f;
            for (int c = 0; c < 128; ++c) { const float p = PW[c * 128 + d];
#pragma unroll
                for (int e = 0; e < 8; ++e) acc[e] += WI[(kq * 8 + e) * 128 + c] * p; }
            const float sc = pool_scale[l * 512 + g * 128 + d];
            v4u o; o.x = pk2(acc[0] * sc, acc[1] * sc); o.y = pk2(acc[2] * sc, acc[3] * sc); o.z = pk2(acc[4] * sc, acc[5] * sc); o.w = pk2(acc[6] * sc, acc[7] * sc);
            bf16* wt = (bf16*)(ws + WS_W + (size_t)l * W_LAYER);
            *(v4u*)(wt + (size_t)(g * 128 + d) * 1024 + k0 + kq * 8) = o;
        }
        __syncthreads();
        LAS float* scr = (LAS float*)(lds + wave * 16384);
        for (int it = gw; it < 6656; it += NGW) {
            const int l = it / 3328; int r = it % 3328;
            bf16* win_t = (bf16*)(ws + WS_W + (size_t)l * W_LAYER); bf16* wpa_t = win_t + (size_t)NIN * 1024; bf16* wout_t = wpa_t + (size_t)1024 * 1024;
            if (r < 2304) { const int kb = r / 144, nb = r % 144; const int n0 = 512 + nb * 32; int trow = n0;
                if (n0 >= 3072) { const int hg = (n0 - 3072) >> 10, ch0 = (n0 - 3072) & 1023; trow = 3072 + (ch0 >> 7) * 256 + ((ch0 >> 5) & 3) * 64 + hg * 32; }
                tr_item(w_in + (size_t)l * DM * NIN, NIN, win_t, 1024, kb * 64, n0, trow, kb * 64, scr, lane); continue; } r -= 2304;
            if (r < 256) { const int kb = r / 32, nb = r % 32; tr_item(w_pool_up + (size_t)l * 512 * 1024, 1024, wpa_t, 1024, kb * 64, nb * 32, nb * 32, kb * 64, scr, lane); continue; } r -= 256;
            if (r < 256) { const int kb = r / 32, nb = r % 32; tr_item(w_attn_up + (size_t)l * 512 * 1024, 1024, wpa_t, 1024, kb * 64, nb * 32, nb * 32, 512 + kb * 64, scr, lane); continue; } r -= 256;
            { const int kb = r / 32, nb = r % 32; tr_item(w_out + (size_t)l * 1024 * 1024, 1024, wout_t, 1024, kb * 64, nb * 32, nb * 32, kb * 64, scr, lane); }
        }
        for (int m = gw; m < T; m += NGW) {
            const f32x4* xr = (const f32x4*)(x + (size_t)m * DM) + 2 * lane; const f32x4* gr = (const f32x4*)norm_g + 2 * lane;
            f32x4 v[4]; float s = 0.f;
#pragma unroll
            for (int jx = 0; jx < 2; ++jx) { v[2 * jx] = xr[128 * jx]; v[2 * jx + 1] = xr[128 * jx + 1]; }
#pragma unroll
            for (int jx = 0; jx < 4; ++jx) s += (v[jx][0] * v[jx][0] + v[jx][1] * v[jx][1]) + (v[jx][2] * v[jx][2] + v[jx][3] * v[jx][3]);
            s = wave_sum(s);
            v4u* o16 = (v4u*)(XG + (size_t)m * DM) + lane;
#pragma unroll
            for (int jx = 0; jx < 2; ++jx) { const f32x4 g0 = gr[128 * jx], g1 = gr[128 * jx + 1]; const f32x4 a = v[2 * jx], b = v[2 * jx + 1]; v4u o;
                o.x = pk2(a[0] * g0[0], a[1] * g0[1]); o.y = pk2(a[2] * g0[2], a[3] * g0[3]); o.z = pk2(b[0] * g1[0], b[1] * g1[1]); o.w = pk2(b[2] * g1[2], b[3] * g1[3]); o16[64 * jx] = o; }
            if (lane < 16) SSP[(size_t)m * 16 + lane] = (lane == 0) ? s : 0.f;
        }
    }
    GRID_BAR();

    for (int l = 0; l < 2; ++l) {
        const bf16* win_t = (const bf16*)(ws + WS_W + (size_t)l * W_LAYER); const bf16* wpa_t = win_t + (size_t)NIN * 1024; const bf16* wout_t = wpa_t + (size_t)1024 * 1024;
#pragma nounroll
        for (int rep = 0; rep < REP_P1; ++rep) {
            if (STAGGER_P1 && ((bx >> 3) & 1)) { const unsigned long long t0 = __builtin_amdgcn_s_memrealtime(); while (__builtin_amdgcn_s_memrealtime() - t0 < (unsigned long long)STAGGER_P1) __builtin_amdgcn_s_sleep(8); }
            pg8::Gemm g{XG, win_t, T, NIN, DM, DM, DM}; pg8::StaticOrder S; S.init(T, NIN, G, bx);
            pg8::EpiProj E{VP, ZP, Qb, Kb, Vb, ZA, Gt, SSP, b_gate + l * 2048};
            pg8::gemm_phase<pg8::EpiProj, pg8::StaticOrder, true, true>(lds, g, S, E); }
#pragma nounroll
        for (int rep = 0; rep < REP_SYNC; ++rep) GRID_BAR();
#pragma nounroll
        for (int rep = 0; rep < REP_P2; ++rep) {   LAS unsigned char* vl = lds + wave * 16384;
            int ln = lane; asm volatile("" : "+v"(ln));
#pragma nounroll
            for (int ph = 0; ph < 2; ++ph) {
                if ((ph == 0) == (wave >= 4)) {
#pragma nounroll
                    for (int r2 = 0; r2 < REP_ATT; ++r2)
                    for (int u = gw; u < NB * NH * (SEQ / 32); u += NGW) { const int hh = u & 7, qt = (u >> 3) & 255, bb = u >> 11;
                        attn_unit(Qb, Kb, Vb, ZA, Yb, bb, hh, qt, vl, ln); }
                } else {
#pragma nounroll
                    for (int r2 = 0; r2 < REP_POOL; ++r2)
                    for (int wt = gw; wt < (T / 32) * 4; wt += NGW) { const int g = wt & 3, tblk = wt >> 2;
                        if (g == 0) pool_wave_task<2>(VP, ZP, Yb, 0, tblk, ln); else if (g == 1) pool_wave_task<4>(VP, ZP, Yb, 1, tblk, ln);
                        else if (g == 2) pool_wave_task<8>(VP, ZP, Yb, 2, tblk, ln); else pool_wave_task<16>(VP, ZP, Yb, 3, tblk, ln); }
                } } }
        GRID_BAR();
#pragma nounroll
        for (int rep = 0; rep < REP_P3A; ++rep) {   pg8::StaticOrder S; S.init(T, DM, G, bx);
            { pg8::Gemm g{Yb, wpa_t, T, DM, DM, DM, DM}; pg8::EpiMergeMid E{MG, Gt}; pg8::gemm_phase<pg8::EpiMergeMid, pg8::StaticOrder, true, true>(lds, g, S, E); } }
        GRID_BAR();
        const bool fuse_norm = (l == 1 && G == 256);
        if (!fuse_norm) {
#pragma nounroll
        for (int rep = 0; rep < (l == 0 ? REP_P3B : 1); ++rep) {   pg8::Gemm g{MG, wout_t, T, DM, DM, DM, DM}; pg8::StaticOrder S; S.init(T, DM, G, bx);
            pg8::EpiOut E{l == 0 ? x : (const float*)out, out, XG, norm_g + 1024, SSP, l == 0 ? 1 : 0};
            pg8::gemm_phase<pg8::EpiOut, pg8::StaticOrder, true, true>(lds, g, S, E); }
        GRID_BAR();
        } else {
            pg8::Gemm g{MG, wout_t, T, DM, DM, DM, DM}; pg8::StaticOrder S; S.init(T, DM, G, bx);
            pg8::EpiOutNorm E{out, out, final_g, (float*)(ws + WS_XBUF), (unsigned*)(ws + WS_PCNT), lds + LDS_XTAB};
            pg8::gemm_phase<pg8::EpiOutNorm, pg8::StaticOrder, true, true>(lds, g, S, E); }
    }
    if (G != 256) {
#pragma nounroll
    for (int rep = 0; rep < REP_FIN; ++rep)
    for (int m = gw; m < T; m += NGW) {
        float ss = SSP[(size_t)m * 16 + (lane & 15)];
        ss += __shfl_xor(ss, 1); ss += __shfl_xor(ss, 2); ss += __shfl_xor(ss, 4); ss += __shfl_xor(ss, 8);
        const float rstd = __builtin_amdgcn_rsqf(ss * (1.0f / 1024.0f) + 1e-6f);
        f32x4* xr = (f32x4*)(out + (size_t)m * DM) + lane; const f32x4* gr = (const f32x4*)final_g + lane;
        f32x4* xw = (rep == REP_FIN - 1) ? xr : (f32x4*)((float*)(ws + WS_G) + (size_t)m * DM) + lane;
#pragma unroll
        for (int jx = 0; jx < 4; ++jx) { const f32x4 v = xr[64 * jx]; xw[64 * jx] = v * rstd * gr[64 * jx]; }
    }
    }
}

extern "C" void kernel_launch(void* const* d_in, const int* in_sizes, int n_in, void* d_out, int out_size, void* d_ws, size_t ws_size, hipStream_t stream) {
    static int grid = 0;
    if (grid == 0) {
        if (n_in != 10 || in_sizes[0] != T * DM || out_size != T * DM || ws_size < WS_END) { fprintf(stderr, "kernel_launch: unexpected shapes / workspace (ws %zu, need %zu)\n", ws_size, (size_t)WS_END); grid = -1; return; }
        int dev = 0, cus = 0, per_cu = 0;
        hipGetDevice(&dev); hipDeviceGetAttribute(&cus, hipDeviceAttributeMultiprocessorCount, dev);
        hipFuncSetAttribute((const void*)fwd_megakernel, hipFuncAttributeMaxDynamicSharedMemorySize, LDS_BYTES);
        hipOccupancyMaxActiveBlocksPerMultiprocessor(&per_cu, (const void*)fwd_megakernel, NTHREADS, LDS_BYTES);
        if (per_cu < 1) { fprintf(stderr, "kernel_launch: occupancy query says %d blocks per CU\n", per_cu); per_cu = 1; }
        grid = cus * per_cu;
    }
    if (grid < 0) return;
    if (hipMemsetAsync((char*)d_ws + WS_BAR, 0, BAR_ZERO_BYTES, stream) != hipSuccess) { fprintf(stderr, "kernel_launch: memset of the barrier words failed\n"); return; }
    Args a{};
    for (int i = 0; i < 10; ++i) a.in[i] = (const float*)d_in[i];
    a.out = (float*)d_out; a.ws = (unsigned char*)d_ws;
    void* kargs[] = {&a};
    hipError_t e = hipLaunchCooperativeKernel((const void*)fwd_megakernel, dim3(grid), dim3(NTHREADS), kargs, LDS_BYTES, stream);
    if (e != hipSuccess) fprintf(stderr, "cooperative launch failed: %s (grid %d)\n", hipGetErrorString(e), grid);
}
```

```cpp
#include <hip/hip_runtime.h>
#include <cstdio>
#include <cstdint>
namespace pg8 {
#define PG8_LAS __attribute__((address_space(3)))
typedef unsigned short bf16_t;
typedef short bf16x8 __attribute__((ext_vector_type(8)));
typedef float f32x4 __attribute__((ext_vector_type(4)));
typedef unsigned u32x4 __attribute__((ext_vector_type(4)));
constexpr int BM = 256, BK = 64, HALF = 128, HTB = HALF * BK * 2  , STAGE_BYTES = 8 * HTB, NXCD = 8, WGM = 8;

__host__ __device__ __forceinline__ int lds_byte(int r, int c) { const int st = (r >> 4) * 2 + (c >> 5), rr = r & 15, cc = c & 31, ob = rr * 64 + cc * 2; return st * 1024 + (ob ^ (((ob >> 9) & 1) << 5)); }
__host__ __device__ __forceinline__ void stage_rc(int b, int& R, int& C) { const int st = b / 1024, sb = b % 1024, swz = sb ^ (((sb >> 9) & 1) << 5); R = (st >> 1) * 16 + swz / 64; C = (st & 1) * 32 + (swz % 64) / 2; }
__host__ __device__ __forceinline__ int perm32(int rho) { const int n = rho >> 4, i = rho & 15; return 8 * (i >> 2) + 4 * n + (i & 3); }

struct Unit { int pm, pn; };
struct Gemm { const bf16_t* A; const bf16_t* Bt; int M, N, K, lda, ldb; };

struct StaticOrder {
    int nM, nN, nwg, G, c;
    __host__ __device__ void init(int M, int N, int G_, int c_) { nM = M / BM; nN = N / BM; nwg = nM * nN; G = G_; c = c_; }
    __host__ __device__ bool next(int i, Unit& u) const {
        const long L = (long)i * G + c; if (L >= nwg) return false;
        int wgid = (int)L; { const int q = nwg / NXCD, r = nwg % NXCD, xcd = wgid % NXCD, off = wgid / NXCD; wgid = (xcd < r ? xcd * (q + 1) : r * (q + 1) + (xcd - r) * q) + off; }
        const int nig = WGM * nN, gid = wgid / nig, fm = gid * WGM, gsz = (nM - fm) < WGM ? (nM - fm) : WGM;
        u.pm = fm + ((wgid % nig) % gsz); u.pn = (wgid % nig) / gsz; return true;
    }
    __device__ __forceinline__ void a_ready(const Unit&) const {}
    __device__ __forceinline__ void done(const Unit&) const {}
};

__device__ __forceinline__ unsigned cvt_pk_bf16(float lo, float hi) { unsigned r; asm volatile("v_cvt_pk_bf16_f32 %0, %1, %2" : "=v"(r) : "v"(lo), "v"(hi)); return r; }
typedef float f32x2 __attribute__((ext_vector_type(2)));
__device__ __forceinline__ float bf_lo(unsigned u) { return __uint_as_float(u << 16); }
__device__ __forceinline__ float bf_hi(unsigned u) { return __uint_as_float(u & 0xffff0000u); }
__device__ __forceinline__ float sigmoid_f(float v) { return __builtin_amdgcn_rcpf(1.0f + __builtin_amdgcn_exp2f(-1.4426950408889634f * v)); }
constexpr float RMS_EPS_F = 1e-6f;
constexpr float QSCALE = 0.125f * 1.4426950408889634f;

struct EpiProj {
    static constexpr bool PERM = true, AFTER_DRAIN = false, HAS_MID = false;
    bf16_t *VP, *ZP, *Q, *K, *V, *ZA, *G; const float* ssp; const float* bgate;
    __device__ __forceinline__ void operator()(const f32x4 (&acc)[2][2][4][2], const Unit& u, int wr, int wc, int fr, int fq) const {
        const int pn = u.pn; bf16_t* base; int ld, mode, colt; float sc = 1.f;
        if (pn < 12) { const int seg = pn >> 1; colt = (pn & 1) * 256; ld = 512;
            base = seg == 0 ? VP : seg == 1 ? ZP : seg == 2 ? Q : seg == 3 ? K : seg == 4 ? V : ZA;
            mode = (seg == 1 || seg == 5) ? 1 : 0; if (seg == 2) sc = QSCALE; }
        else { base = G; colt = (pn - 12) * 256; ld = 2048; mode = 2; }
        const int row0 = u.pm * BM + wr * 64 + fr, col0 = colt + wc * 64 + 8 * fq;
        const int chan0 = (pn - 12) * 128 + wc * 32 + 8 * fq;
        f32x4 bv[2][2];
#pragma unroll
        for (int bj = 0; bj < 2; ++bj)
#pragma unroll
            for (int n = 0; n < 2; ++n) bv[bj][n] = (mode == 2) ? *(const f32x4*)(bgate + bj * 1024 + chan0 + 4 * n) * -1.4426950408889634f : (f32x4){0.f, 0.f, 0.f, 0.f};
#pragma unroll
        for (int ai = 0; ai < 2; ++ai)
#pragma unroll
            for (int m = 0; m < 4; ++m) { const int row = row0 + ai * HALF + m * 16;
                const f32x4 st = *((const f32x4*)(ssp + (size_t)row * 16) + fq);
                float ss = (st[0] + st[1]) + (st[2] + st[3]); ss += __shfl_xor(ss, 16); ss += __shfl_xor(ss, 32);
                const float rstd = __builtin_amdgcn_rsqf(ss * (1.0f / 1024.0f) + RMS_EPS_F) * sc;
                bf16_t* rowp = base + (size_t)row * ld + col0;
                if (mode == 2) {
                    const float nr = -1.4426950408889634f * rstd; f32x4 rr[2], mm[2];
#pragma unroll
                    for (int n = 0; n < 2; ++n)
#pragma unroll
                        for (int e = 0; e < 4; ++e) { const float d0 = 1.0f + __builtin_amdgcn_exp2f(__builtin_fmaf(acc[ai][0][m][n][e], nr, bv[0][n][e]));
                            const float d1 = __builtin_fminf(1.0f + __builtin_amdgcn_exp2f(__builtin_fmaf(acc[ai][1][m][n][e], nr, bv[1][n][e])), 1.2676506002282294e30f);
                            mm[n][e] = __builtin_amdgcn_rcpf(d1); rr[n][e] = d1 * __builtin_amdgcn_rcpf(d0); }
                    bf16_t* gp = G + (size_t)row * 2048 + chan0;
                    u32x4 w; w.x = cvt_pk_bf16(rr[0][0], rr[0][1]); w.y = cvt_pk_bf16(rr[0][2], rr[0][3]); w.z = cvt_pk_bf16(rr[1][0], rr[1][1]); w.w = cvt_pk_bf16(rr[1][2], rr[1][3]);
                    __builtin_nontemporal_store(w, (u32x4*)gp);
                    w.x = cvt_pk_bf16(mm[0][0], mm[0][1]); w.y = cvt_pk_bf16(mm[0][2], mm[0][3]); w.z = cvt_pk_bf16(mm[1][0], mm[1][1]); w.w = cvt_pk_bf16(mm[1][2], mm[1][3]);
                    __builtin_nontemporal_store(w, (u32x4*)(gp + 1024));
                } else
#pragma unroll
                for (int bj = 0; bj < 2; ++bj) { f32x4 v0, v1;
                    v0 = acc[ai][bj][m][0] * rstd; v1 = acc[ai][bj][m][1] * rstd;
                    if (mode == 1) {
#pragma unroll
                        for (int e = 0; e < 4; ++e) { v0[e] = v0[e] * sigmoid_f(v0[e]); v1[e] = v1[e] * sigmoid_f(v1[e]); } }
                    u32x4 w; w.x = cvt_pk_bf16(v0[0], v0[1]); w.y = cvt_pk_bf16(v0[2], v0[3]); w.z = cvt_pk_bf16(v1[0], v1[1]); w.w = cvt_pk_bf16(v1[2], v1[3]);
                    __builtin_nontemporal_store(w, (u32x4*)(rowp + bj * 32)); } }
    }
};
struct EpiMergeMid {
    static constexpr bool PERM = true, AFTER_DRAIN = false, HAS_MID = true;
    bf16_t* MG; const bf16_t* G;
    __device__ __forceinline__ void mid(f32x4 (&acc)[2][2][4][2], const Unit& u, int wr, int wc, int fr, int fq) const {
        const int row0 = u.pm * BM + wr * 64 + fr, col0 = u.pn * BM + wc * 64 + 8 * fq;
#pragma unroll
        for (int ai = 0; ai < 2; ++ai)
#pragma unroll
            for (int m = 0; m < 4; ++m) { const int row = row0 + ai * HALF + m * 16;
#pragma unroll
                for (int bj = 0; bj < 2; ++bj) { const u32x4 a = *(const u32x4*)(G + (size_t)row * 2048 + col0 + bj * 32);
                    f32x4& v0 = acc[ai][bj][m][0]; f32x4& v1 = acc[ai][bj][m][1];
                    v0[0] *= bf_lo(a.x); v0[1] *= bf_hi(a.x); v0[2] *= bf_lo(a.y); v0[3] *= bf_hi(a.y);
                    v1[0] *= bf_lo(a.z); v1[1] *= bf_hi(a.z); v1[2] *= bf_lo(a.w); v1[3] *= bf_hi(a.w); } }
    }
    __device__ __forceinline__ void operator()(const f32x4 (&acc)[2][2][4][2], const Unit& u, int wr, int wc, int fr, int fq) const {
        const int row0 = u.pm * BM + wr * 64 + fr, col0 = u.pn * BM + wc * 64 + 8 * fq;
#pragma unroll
        for (int ai = 0; ai < 2; ++ai)
#pragma unroll
            for (int m = 0; m < 4; ++m) { const int row = row0 + ai * HALF + m * 16;
#pragma unroll
                for (int bj = 0; bj < 2; ++bj) { const int col = col0 + bj * 32;
                    const u32x4 b = *(const u32x4*)(G + (size_t)row * 2048 + 1024 + col);
                    const f32x4 v0 = acc[ai][bj][m][0], v1 = acc[ai][bj][m][1];
                    u32x4 w; w.x = cvt_pk_bf16(v0[0] * bf_lo(b.x), v0[1] * bf_hi(b.x)); w.y = cvt_pk_bf16(v0[2] * bf_lo(b.y), v0[3] * bf_hi(b.y));
                    w.z = cvt_pk_bf16(v1[0] * bf_lo(b.z), v1[1] * bf_hi(b.z)); w.w = cvt_pk_bf16(v1[2] * bf_lo(b.w), v1[3] * bf_hi(b.w));
                    *(u32x4*)(MG + (size_t)row * 1024 + col) = w; } }
    }
};
struct EpiOut {
    static constexpr bool PERM = true, AFTER_DRAIN = false, HAS_MID = false;
    const float* xin; float* xout; bf16_t* XG; const float* gnext; float* ssp; int write_xg;
    __device__ __forceinline__ void operator()(const f32x4 (&acc)[2][2][4][2], const Unit& u, int wr, int wc, int fr, int fq) const {
        const int col0 = u.pn * BM + wc * 64 + 8 * fq;
#pragma unroll
        for (int ai = 0; ai < 2; ++ai)
#pragma unroll
            for (int m = 0; m < 4; ++m) { const int row = u.pm * BM + ai * HALF + wr * 64 + m * 16 + fr; const size_t off = (size_t)row * 1024 + col0; float ss = 0.f;
#pragma unroll
                for (int bj = 0; bj < 2; ++bj) { const int co = bj * 32;
                    const f32x4 v0 = *(const f32x4*)(xin + off + co) + acc[ai][bj][m][0], v1 = *(const f32x4*)(xin + off + co + 4) + acc[ai][bj][m][1];
                    __builtin_nontemporal_store(v0, (f32x4*)(xout + off + co)); __builtin_nontemporal_store(v1, (f32x4*)(xout + off + co + 4));
                    ss += ((v0[0] * v0[0] + v0[1] * v0[1]) + (v0[2] * v0[2] + v0[3] * v0[3])) + ((v1[0] * v1[0] + v1[1] * v1[1]) + (v1[2] * v1[2] + v1[3] * v1[3]));
                    if (write_xg) { const f32x4 g0 = *(const f32x4*)(gnext + col0 + co), g1 = *(const f32x4*)(gnext + col0 + co + 4);
                        u32x4 w; w.x = cvt_pk_bf16(v0[0] * g0[0], v0[1] * g0[1]); w.y = cvt_pk_bf16(v0[2] * g0[2], v0[3] * g0[3]); w.z = cvt_pk_bf16(v1[0] * g1[0], v1[1] * g1[1]); w.w = cvt_pk_bf16(v1[2] * g1[2], v1[3] * g1[3]);
                        *(u32x4*)(XG + off + co) = w; } }
                ss += __shfl_xor(ss, 16); ss += __shfl_xor(ss, 32);
                if (fq == 0) ssp[(size_t)row * 16 + u.pn * 4 + wc] = ss; }
    }
};

struct EpiOutNorm {
    static constexpr bool PERM = false, AFTER_DRAIN = false, HAS_MID = false;
    const float* xin; float* out; const float* fg; float* xbuf; unsigned* cnt; PG8_LAS unsigned char* lx;
    __device__ __forceinline__ void operator()(f32x4 (&acc)[2][2][4][2], const Unit& u, int wr, int wc, int fr, int fq) const {
        PG8_LAS float* P = (PG8_LAS float*)lx;
        PG8_LAS float* S = (PG8_LAS float*)(lx + 4096);
        const int col0 = u.pn * BM + wc * 64 + 4 * fq, wid = wr * 4 + wc, lane = fq * 16 + fr;
#pragma unroll
        for (int ai = 0; ai < 2; ++ai)
#pragma unroll
            for (int m = 0; m < 4; ++m) { const int rl = ai * HALF + wr * 64 + m * 16 + fr; const size_t off = (size_t)(u.pm * BM + rl) * 1024 + col0; float ss = 0.f;
#pragma unroll
                for (int bj = 0; bj < 2; ++bj)
#pragma unroll
                    for (int n = 0; n < 2; ++n) { const f32x4 v = *(const f32x4*)(xin + off + bj * 32 + n * 16) + acc[ai][bj][m][n]; acc[ai][bj][m][n] = v;
                        ss += (v[0] * v[0] + v[1] * v[1]) + (v[2] * v[2] + v[3] * v[3]); }
                ss += __shfl_xor(ss, 16); ss += __shfl_xor(ss, 32);
                if (fq == 0) P[rl * 4 + wc] = ss;
                if (m & 1) asm volatile("" ::: "memory"); }
        asm volatile("s_waitcnt lgkmcnt(0)" ::: "memory"); __builtin_amdgcn_s_barrier(); asm volatile("" ::: "memory");
        const int rowl = wid * 32 + (lane & 31);
        if (lane < 32) { const float ts = (P[rowl * 4 + 0] + P[rowl * 4 + 1]) + (P[rowl * 4 + 2] + P[rowl * 4 + 3]);
            __hip_atomic_store(xbuf + ((size_t)(u.pm * BM + rowl) * 4 + u.pn), ts, __ATOMIC_RELAXED, __HIP_MEMORY_SCOPE_AGENT); }
        asm volatile("s_waitcnt vmcnt(0)" ::: "memory");
        if (lane == 0) __hip_atomic_fetch_add(cnt + 64 * u.pm, 1u, __ATOMIC_RELAXED, __HIP_MEMORY_SCOPE_AGENT);
        if (wid == 0) { unsigned spins = 0;
            while ((unsigned)__builtin_amdgcn_readfirstlane(__hip_atomic_load(cnt + 64 * u.pm, __ATOMIC_RELAXED, __HIP_MEMORY_SCOPE_AGENT)) < 32u) { __builtin_amdgcn_s_sleep(2); if (++spins > (1u << 22)) break; }
            __builtin_amdgcn_fence(__ATOMIC_ACQUIRE, "agent"); }
        asm volatile("s_waitcnt vmcnt(0) lgkmcnt(0)" ::: "memory"); __builtin_amdgcn_s_barrier(); asm volatile("" ::: "memory");
        if (lane < 32) { const float* slot = xbuf + (size_t)(u.pm * BM + rowl) * 4; float q = 0.f;
#pragma unroll
            for (int t = 0; t < 4; ++t) q += __hip_atomic_load(slot + t, __ATOMIC_RELAXED, __HIP_MEMORY_SCOPE_AGENT);
            S[rowl] = __builtin_amdgcn_rsqf(q * (1.0f / 1024.0f) + RMS_EPS_F); }
        asm volatile("s_waitcnt lgkmcnt(0)" ::: "memory"); __builtin_amdgcn_s_barrier(); asm volatile("" ::: "memory");
        f32x4 gv[2][2];
#pragma unroll
        for (int bj = 0; bj < 2; ++bj)
#pragma unroll
            for (int n = 0; n < 2; ++n) gv[bj][n] = *(const f32x4*)(fg + col0 + bj * 32 + n * 16);
#pragma unroll
        for (int ai = 0; ai < 2; ++ai)
#pragma unroll
            for (int m = 0; m < 4; ++m) { const int rl = ai * HALF + wr * 64 + m * 16 + fr; const float rs = S[rl]; const size_t off = (size_t)(u.pm * BM + rl) * 1024 + col0;
#pragma unroll
                for (int bj = 0; bj < 2; ++bj)
#pragma unroll
                    for (int n = 0; n < 2; ++n) __builtin_nontemporal_store(acc[ai][bj][m][n] * rs * gv[bj][n], (f32x4*)(out + off + bj * 32 + n * 16)); }
    }
};
template <class Epi, class Sched, bool ALIGN_EPI = false, bool SP2 = false>
__device__ __forceinline__ void gemm_phase(PG8_LAS unsigned char* lds, const Gemm g_in, const Sched& S, const Epi& E) {
    Gemm g = g_in; asm volatile("" : "+s"(g.A), "+s"(g.Bt));
    int tid_ = threadIdx.x; asm volatile("" : "+v"(tid_));
    const int tid = tid_, wid = __builtin_amdgcn_readfirstlane(tid >> 6), lane = tid & 63, wr = wid >> 2, wc = wid & 3, fr = lane & 15, fq = lane >> 4;
    const int K = g.K, nt = K / BK;
    unsigned voffA[2], voffB[2];
#pragma unroll
    for (int i = 0; i < 2; ++i) { int R, C; stage_rc(tid * 16 + i * 8192, R, C); const int Rb = 2 * (R & ~31) + (Epi::PERM ? perm32(R & 31) : (R & 31));
        voffA[i] = (unsigned)(R * g.lda + C) * 2u; voffB[i] = (unsigned)(Rb * g.ldb + C) * 2u; }
    const size_t kstep = (size_t)(BK * 2);
    const size_t hstepA = (size_t)HALF * g.lda * 2, hstepB = (size_t)32 * g.ldb * 2;
    const size_t tstepA = 2 * hstepA, tstepB = (size_t)BM * g.ldb * 2;
    const unsigned ldsw = (unsigned)wid * 1024u;
    const int aoff = lds_byte(wr * 64 + fr, fq * 8), boff = lds_byte(wc * 32 + fr, fq * 8);
#define PG8_SA(b, h) (((b) * 2 + (h)) * HTB)
#define PG8_SB(b, h) ((4 + (b) * 2 + (h)) * HTB)
#define PG8_STAGE(bufoff, gbase, voff) do { _Pragma("unroll") for (int _i = 0; _i < 2; ++_i) \
        __builtin_amdgcn_global_load_lds((const unsigned*)((const char*)(gbase) + (voff)[_i]), (PG8_LAS unsigned*)(lds + (bufoff) + ldsw + _i * 8192), 16, 0, 0); } while (0)
#define PG8_LDA(dst, b, h) do { _Pragma("unroll") for (int m = 0; m < 4; ++m) _Pragma("unroll") for (int k = 0; k < 2; ++k) dst[m][k] = *(const PG8_LAS bf16x8*)(lds + PG8_SA(b, h) + aoff + m * 2048 + k * 1024); } while (0)
#define PG8_LDB(dst, b, h) do { _Pragma("unroll") for (int n = 0; n < 2; ++n) _Pragma("unroll") for (int k = 0; k < 2; ++k) dst[n][k] = *(const PG8_LAS bf16x8*)(lds + PG8_SB(b, h) + boff + n * 2048 + k * 1024); } while (0)
#define PG8_MMA(ai, bj, At, Bt) do { __builtin_amdgcn_s_setprio(1); _Pragma("unroll") for (int m = 0; m < 4; ++m) _Pragma("unroll") for (int n = 0; n < 2; ++n) _Pragma("unroll") for (int k = 0; k < 2; ++k) \
        acc[ai][bj][m][n] = __builtin_amdgcn_mfma_f32_16x16x32_bf16(Bt[n][k], At[m][k], acc[ai][bj][m][n], 0, 0, 0); __builtin_amdgcn_s_setprio(0); } while (0)
#define PG8_WAIT_V(n) asm volatile("s_waitcnt vmcnt(" #n ")" ::: "memory")
#define PG8_WAIT_L(n) asm volatile("s_waitcnt lgkmcnt(" #n ")" ::: "memory")
#define PG8_BAR __builtin_amdgcn_s_barrier()
#define PG8_SCHED __builtin_amdgcn_sched_barrier(0)
    Unit cur, nxt; int ui = 0;
    if (!S.next(0, cur)) return;
    f32x4 acc[2][2][4][2];
#pragma unroll
    for (int a = 0; a < 2; ++a)
#pragma unroll
        for (int b = 0; b < 2; ++b)
#pragma unroll
            for (int m = 0; m < 4; ++m)
#pragma unroll
                for (int n = 0; n < 2; ++n) acc[a][b][m][n] = (f32x4){0.f, 0.f, 0.f, 0.f};
    bf16x8 At[4][2], B0[2][2], B1[2][2];
    const char* cA = (const char*)g.A + (size_t)cur.pm * tstepA; const char* cB = (const char*)g.Bt + (size_t)cur.pn * tstepB;
    S.a_ready(cur);
    if constexpr (SP2) {
        PG8_STAGE(PG8_SB(0, 0), cB, voffB); PG8_STAGE(PG8_SB(0, 1), cB + hstepB, voffB); PG8_STAGE(PG8_SA(0, 0), cA, voffA); PG8_STAGE(PG8_SA(0, 1), cA + hstepA, voffA);
        if (wr == 1) PG8_BAR;
        PG8_WAIT_V(2); PG8_BAR;
        PG8_STAGE(PG8_SB(1, 0), cB + kstep, voffB); PG8_STAGE(PG8_SA(1, 0), cA + kstep, voffA); PG8_STAGE(PG8_SB(1, 1), cB + hstepB + kstep, voffB);
        PG8_WAIT_V(6); PG8_BAR;
    } else {
        PG8_STAGE(PG8_SB(0, 0), cB, voffB); PG8_STAGE(PG8_SA(0, 0), cA, voffA); PG8_STAGE(PG8_SB(0, 1), cB + hstepB, voffB); PG8_STAGE(PG8_SA(0, 1), cA + hstepA, voffA);
        if (wr == 1) PG8_BAR;
        PG8_WAIT_V(4); PG8_BAR;
        PG8_STAGE(PG8_SB(1, 0), cB + kstep, voffB); PG8_STAGE(PG8_SA(1, 0), cA + kstep, voffA); PG8_STAGE(PG8_SB(1, 1), cB + hstepB + kstep, voffB);
        PG8_WAIT_V(6); PG8_BAR;
    }
    for (;;) {
        const bool has_next = S.next(ui + 1, nxt);
        const char* nA = has_next ? (const char*)g.A + (size_t)nxt.pm * tstepA : cA; const char* nB = has_next ? (const char*)g.Bt + (size_t)nxt.pn * tstepB : cB;
        for (int t = 0; t < nt; t += 2) {
            if constexpr (Epi::HAS_MID) { if (t == (nt >> 1)) { int fr_ = fr, fq_ = fq; asm volatile("" : "+v"(fr_), "+v"(fq_)); E.mid(acc, cur, wr, wc, fr_, fq_); } }
            const bool last = (t == nt - 2);
            const char* a1 = cA + (size_t)(t + 1) * kstep;
            const char* a2 = last ? nA : cA + (size_t)(t + 2) * kstep; const char* b2 = last ? nB : cB + (size_t)(t + 2) * kstep;
            const char* a3 = a2 + kstep; const char* b3 = b2 + kstep;
            if (last && has_next) S.a_ready(nxt);
            if constexpr (SP2) {
            PG8_LDB(B0, 0, 0); PG8_LDB(B1, 0, 1); PG8_SCHED; PG8_LDA(At, 0, 0); PG8_STAGE(PG8_SA(1, 1), a1 + hstepA, voffA);
            PG8_WAIT_V(8); PG8_WAIT_L(0); PG8_BAR; PG8_MMA(0, 0, At, B0); PG8_MMA(0, 1, At, B1); PG8_BAR; PG8_SCHED;
            PG8_LDA(At, 0, 1); PG8_STAGE(PG8_SB(0, 0), b2, voffB); PG8_STAGE(PG8_SB(0, 1), b2 + hstepB, voffB); PG8_STAGE(PG8_SA(0, 0), a2, voffA);
            PG8_WAIT_V(8); PG8_WAIT_L(0); PG8_BAR; PG8_MMA(1, 0, At, B0); PG8_MMA(1, 1, At, B1); PG8_BAR; PG8_SCHED;
            PG8_LDB(B0, 1, 0); PG8_LDB(B1, 1, 1); PG8_SCHED; PG8_LDA(At, 1, 0); PG8_STAGE(PG8_SA(0, 1), a2 + hstepA, voffA);
            PG8_WAIT_V(8); PG8_WAIT_L(0); PG8_BAR; PG8_MMA(0, 0, At, B0); PG8_MMA(0, 1, At, B1); PG8_BAR; PG8_SCHED;
            PG8_LDA(At, 1, 1); PG8_STAGE(PG8_SB(1, 0), b3, voffB); PG8_STAGE(PG8_SB(1, 1), b3 + hstepB, voffB); PG8_STAGE(PG8_SA(1, 0), a3, voffA);
            PG8_WAIT_V(8); PG8_WAIT_L(0); PG8_BAR; PG8_MMA(1, 0, At, B0); PG8_MMA(1, 1, At, B1); PG8_BAR; PG8_SCHED;
            } else {
            PG8_LDB(B0, 0, 0); PG8_SCHED; PG8_LDA(At, 0, 0); PG8_STAGE(PG8_SA(1, 1), a1 + hstepA, voffA);
            PG8_WAIT_L(8); PG8_BAR; PG8_WAIT_L(0); PG8_MMA(0, 0, At, B0); PG8_BAR; PG8_SCHED;
            PG8_LDB(B1, 0, 1); PG8_STAGE(PG8_SB(0, 0), b2, voffB);
            PG8_BAR; PG8_WAIT_L(0); PG8_MMA(0, 1, At, B1); PG8_BAR;
            PG8_LDA(At, 0, 1); PG8_STAGE(PG8_SA(0, 0), a2, voffA);
            PG8_BAR; PG8_WAIT_L(0); PG8_MMA(1, 0, At, B0); PG8_BAR; PG8_SCHED;
            PG8_STAGE(PG8_SB(0, 1), b2 + hstepB, voffB);
            PG8_WAIT_V(6); PG8_BAR; PG8_MMA(1, 1, At, B1); PG8_BAR;
            PG8_LDB(B0, 1, 0); PG8_SCHED; PG8_LDA(At, 1, 0); PG8_STAGE(PG8_SA(0, 1), a2 + hstepA, voffA);
            PG8_WAIT_L(8); PG8_BAR; PG8_WAIT_L(0); PG8_MMA(0, 0, At, B0); PG8_BAR; PG8_SCHED;
            PG8_LDB(B1, 1, 1); PG8_STAGE(PG8_SB(1, 0), b3, voffB);
            PG8_BAR; PG8_WAIT_L(0); PG8_MMA(0, 1, At, B1); PG8_BAR;
            PG8_LDA(At, 1, 1); PG8_STAGE(PG8_SA(1, 0), a3, voffA);
            PG8_BAR; PG8_WAIT_L(0); PG8_MMA(1, 0, At, B0); PG8_BAR; PG8_SCHED;
            PG8_STAGE(PG8_SB(1, 1), b3 + hstepB, voffB);
            PG8_WAIT_V(6); PG8_BAR; PG8_MMA(1, 1, At, B1); PG8_BAR;
            }
        }
        if constexpr (ALIGN_EPI) { if (wr == 0) PG8_BAR; }
        if constexpr (!Epi::AFTER_DRAIN) { int fr_ = fr, fq_ = fq; asm volatile("" : "+v"(fr_), "+v"(fq_));   E(acc, cur, wr, wc, fr_, fq_); S.done(cur); }
        if (!has_next) break;
#pragma unroll
        for (int a = 0; a < 2; ++a)
#pragma unroll
            for (int b = 0; b < 2; ++b)
#pragma unroll
                for (int m = 0; m < 4; ++m)
#pragma unroll
                    for (int n = 0; n < 2; ++n) acc[a][b][m][n] = (f32x4){0.f, 0.f, 0.f, 0.f};
        cur = nxt; cA = nA; cB = nB; ++ui;
        if constexpr (ALIGN_EPI) { if (wr == 1) PG8_BAR; }
    }
    PG8_WAIT_V(0);
    if constexpr (!ALIGN_EPI) { if (wr == 0) PG8_BAR; }
    PG8_BAR;
    if constexpr (Epi::AFTER_DRAIN) { E.fused(acc, cur, wr, wc, fr, fq, lds, wid, lane); S.done(cur); }
#undef PG8_SA
#undef PG8_SB
#undef PG8_STAGE
#undef PG8_LDA
#undef PG8_LDB
#undef PG8_MMA
#undef PG8_WAIT_V
#undef PG8_WAIT_L
#undef PG8_BAR
#undef PG8_SCHED
}
}
#define LAS __attribute__((address_space(3)))
typedef unsigned short bf16;
typedef unsigned v4u __attribute__((ext_vector_type(4)));
typedef unsigned v2u __attribute__((ext_vector_type(2)));
typedef float f32x4 __attribute__((ext_vector_type(4)));
typedef float f32x16 __attribute__((ext_vector_type(16)));
typedef short bf16x8 __attribute__((ext_vector_type(8)));
typedef short s16x4 __attribute__((ext_vector_type(4)));
constexpr int NB = 4, SEQ = 8192, DM = 1024, T = NB * SEQ, NIN = 5120, NH = 8;
constexpr size_t MiB = 1u << 20;
constexpr size_t WS_BAR = 0, WS_PCNT = 16384, BAR_ZERO_BYTES = 65536;
constexpr size_t WS_XBUF = 3 * MiB;
constexpr size_t WS_SSP = 1 * MiB;
constexpr size_t WS_W = 4 * MiB, W_LAYER = 14 * MiB;
constexpr size_t WS_XG = 32 * MiB;
constexpr size_t WS_VP = 96 * MiB, WS_ZP = 128 * MiB, WS_Q = 160 * MiB, WS_K = 192 * MiB, WS_V = 224 * MiB, WS_ZA = 256 * MiB;
constexpr size_t WS_G = 288 * MiB;
constexpr size_t WS_Y = 416 * MiB;
constexpr size_t WS_MG = WS_Q;
constexpr size_t WS_END = 480 * MiB;
constexpr int LDS_BYTES = 147456;
constexpr int LDS_XTAB = 131072;
constexpr int LDS_MISC = 139264;
constexpr int NWAVES = 8, NTHREADS = 512;
constexpr int STAGGER_P1 = 0;
constexpr int REP_P0 = 1, REP_P1 = 1, REP_P2 = 1, REP_P3A = 1, REP_SYNC = 1, REP_P3B = 1, REP_FIN = 1, REP_ATT = 1, REP_POOL = 1;

__device__ __forceinline__ unsigned f2bf(float f) { unsigned u = __builtin_bit_cast(unsigned, f); return (u + 0x7fffu + ((u >> 16) & 1u)) >> 16; }
__device__ __forceinline__ unsigned pk2(float lo, float hi) { return f2bf(lo) | (f2bf(hi) << 16); }
typedef float f32x2_t __attribute__((ext_vector_type(2))); typedef __bf16 bf16x2_t __attribute__((ext_vector_type(2)));
__device__ __forceinline__ unsigned cvtpk(float lo, float hi) { f32x2_t v = {lo, hi}; bf16x2_t b = __builtin_convertvector(v, bf16x2_t); return __builtin_bit_cast(unsigned, b); }
__device__ __forceinline__ float bflo(unsigned u) { return __uint_as_float(u << 16); }
__device__ __forceinline__ float bfhi(unsigned u) { return __uint_as_float(u & 0xffff0000u); }
__device__ __forceinline__ float wave_sum(float v) {
#pragma unroll
    for (int o = 1; o < 64; o <<= 1) v += __shfl_xor(v, o);
    return v;
}
#define LDS_WAIT() asm volatile("s_waitcnt lgkmcnt(0)" ::: "memory")

__device__ __forceinline__ void tr_item(const float* W, int ldw, bf16* WT, int ldt, int k0, int n0, int trow0, int tcol0, LAS float* scr, int lane) {
#pragma unroll 8
    for (int i = 0; i < 32; ++i) { const int kk = 2 * i + (lane >> 5); scr[kk * 33 + (lane & 31)] = W[(size_t)(k0 + kk) * ldw + n0 + (lane & 31)]; }
    LDS_WAIT();
    const int c = lane & 7;
#pragma unroll
    for (int j = 0; j < 4; ++j) { const int n = (lane >> 3) + 8 * j; const LAS float* s = scr + (8 * c) * 33 + n;
        v4u o; o.x = pk2(s[0 * 33], s[1 * 33]); o.y = pk2(s[2 * 33], s[3 * 33]); o.z = pk2(s[4 * 33], s[5 * 33]); o.w = pk2(s[6 * 33], s[7 * 33]);
        *(v4u*)(WT + (size_t)(trow0 + n) * ldt + tcol0 + 8 * c) = o; }
    LDS_WAIT();
}

#define RLX_AGENT __ATOMIC_RELAXED, __HIP_MEMORY_SCOPE_AGENT
#define XB_TMO      128
#define XB_XCNT(j)  (256  + 64 * (j))
#define XB_XSUB(j)  (1280 + 64 * (j))
#define XB_XGEN(j)  (2304 + 64 * (j))
#define XB_TOP      3328
#define XB_TOPGEN   3392
#define XCD_BAR_WORDS 3456
#define XB_SPIN_CAP (1u << 18)

__device__ __forceinline__ unsigned xb_ld(unsigned* p)              { return __hip_atomic_load(p, __ATOMIC_RELAXED, __HIP_MEMORY_SCOPE_AGENT); }
__device__ __forceinline__ unsigned xb_add(unsigned* p, unsigned v) { return __hip_atomic_fetch_add(p, v, __ATOMIC_RELAXED, __HIP_MEMORY_SCOPE_AGENT); }
__device__ __forceinline__ unsigned xb_xcc_id() { return (unsigned)__builtin_amdgcn_s_getreg((3 << 11) | 20) & 0xFu; }
#define XB_SPIN(cond, bar) do { unsigned _sp = 0; while (cond) { __builtin_amdgcn_s_sleep(1); \
    if ((++_sp & 255u) == 0u) { if (xb_ld(&(bar)[XB_TMO])) break; if (_sp > XB_SPIN_CAP) { atomicAdd(&(bar)[XB_TMO], 1u); break; } } } } while (0)

struct XcdBarrier {
    unsigned* bar; unsigned x;
    volatile LAS unsigned* st;
};

__device__ __forceinline__ XcdBarrier xcd_barrier_post(unsigned* bar, volatile LAS unsigned* st) {
    XcdBarrier b; b.bar = bar; b.x = xb_xcc_id(); b.st = st;
    if (threadIdx.x == 0) (void)xb_add(&bar[XB_XCNT(b.x)], 1u);
    return b;
}
__device__ __forceinline__ void xcd_barrier_complete(unsigned* bar, unsigned x, unsigned& nloc, unsigned& nx) {
    const unsigned G = gridDim.x * gridDim.y * gridDim.z;
    unsigned sum, cnt, mine, sp = 0u;
    for (;;) {
        sum = 0u; cnt = 0u; mine = 0u;
#pragma unroll
        for (unsigned j = 0; j < 16; ++j) { const unsigned c = xb_ld(&bar[XB_XCNT(j)]); sum += c; cnt += (c > 0u) ? 1u : 0u; mine = (j == x) ? c : mine; }
        if (sum == G) break;
        __builtin_amdgcn_s_sleep(1);
        if ((++sp & 255u) == 0u) { if (xb_ld(&bar[XB_TMO])) break; if (sp > XB_SPIN_CAP) { atomicAdd(&bar[XB_TMO], 1u); break; } }
    }
    nloc = mine > 0u ? mine : 1u; nx = cnt > 0u ? cnt : 1u;
}

__device__ __forceinline__ void xcd_barrier(const XcdBarrier& b) {
    asm volatile("s_waitcnt vmcnt(0)" ::: "memory");
    __syncthreads();
    if (threadIdx.x == 0) {
        unsigned* bar = b.bar;
        __builtin_amdgcn_s_waitcnt(0);
        unsigned nloc = b.st[0], nx = b.st[1];
        if (nloc == 0u) { xcd_barrier_complete(bar, b.x, nloc, nx); b.st[0] = nloc; b.st[1] = nx; }
        const unsigned old = xb_add(&bar[XB_XSUB(b.x)], 1u);
        const unsigned gen = old / nloc;
        if (old + 1u == (gen + 1u) * nloc) {
            __builtin_amdgcn_fence(__ATOMIC_RELEASE, "agent");
            asm volatile("s_waitcnt vmcnt(0)" ::: "memory");
            const unsigned og = xb_add(&bar[XB_TOP], 1u);
            const unsigned tg = og / nx;
            if (og + 1u == (tg + 1u) * nx) xb_add(&bar[XB_TOPGEN], 1u);
            else XB_SPIN(xb_ld(&bar[XB_TOPGEN]) == tg, bar);
            __builtin_amdgcn_fence(__ATOMIC_ACQUIRE, "agent");
            xb_add(&bar[XB_XGEN(b.x)], 1u);
            asm volatile("s_waitcnt vmcnt(0)" ::: "memory");
        } else {
            XB_SPIN(xb_ld(&bar[XB_XGEN(b.x)]) == gen, bar);
            __builtin_amdgcn_fence(__ATOMIC_ACQUIRE, "agent");
            asm volatile("s_waitcnt vmcnt(0)" ::: "memory");
        }
    }
    __syncthreads();
}
constexpr int VPITCH = 144;
constexpr float SB_EXIT = 1.17549435e-38f;
__device__ __forceinline__ int crow(int r, int hi) { return (r & 3) + 8 * (r >> 2) + 4 * hi; }
__device__ __forceinline__ s16x4 vtr(const LAS unsigned char* p) { typedef short v4i16_t __attribute__((ext_vector_type(4)));
    return __builtin_bit_cast(s16x4, __builtin_amdgcn_ds_read_tr16_b64_v4i16((LAS v4i16_t*)p)); }
constexpr int KOFF = 4608, OPITCH = 272;
__device__ __forceinline__ bool attn_tile(v4u (&kc)[4], v4u (&vc)[4], v4u (&kl)[4], v4u (&vl2)[4], const bf16*& kp, const bf16*& vp, int kt, int qt,
                                          const bf16x8 (&qf)[4], f32x16& o0, f32x16& o1, float& pc, LAS unsigned char* vl, unsigned vwb, unsigned frb, unsigned trb, int j, int hi) {
    {
        const int step = (kt > 1) ? 32 * 512 : 0; kp -= step; vp -= step;
#pragma unroll
        for (int i = 0; i < 4; ++i) kl[i] = *(const v4u*)(kp + (size_t)i * 8 * 512);
#pragma unroll
        for (int i = 0; i < 4; ++i) vl2[i] = *(const v4u*)(vp + (size_t)i * 8 * 512);
    }
#pragma unroll
    for (int i = 0; i < 4; ++i) { *(LAS v4u*)(vl + KOFF + vwb + i * 8 * VPITCH) = kc[i]; *(LAS v4u*)(vl + vwb + i * 8 * VPITCH) = vc[i]; }
    asm volatile("" ::: "memory");
    f32x16 sc;
#pragma unroll
    for (int r = 0; r < 16; ++r) sc[r] = 0.f;
#pragma unroll
    for (int s = 0; s < 4; ++s) { const bf16x8 kf = *(const LAS bf16x8*)(vl + KOFF + frb + 32 * s);
        sc = __builtin_amdgcn_mfma_f32_32x32x16_bf16(kf, qf[s], sc, 0, 0, 0); }
    const bool diag = (kt == qt);
    float be[16], om[16];
#pragma unroll
    for (int r = 0; r < 16; ++r) { const float bb = __builtin_amdgcn_rcpf(1.0f + __builtin_amdgcn_exp2f(-sc[r]));
        be[r] = bb; om[r] = 1.0f - bb; }
    if (diag) {
#pragma unroll
        for (int r = 0; r < 16; ++r) if (crow(r, hi) >= j) { be[r] = 0.f; om[r] = 1.0f; } }
    float Rp[4], Tt[4];
#pragma unroll
    for (int a = 0; a < 4; ++a) { const float R = (om[4 * a] * om[4 * a + 1]) * (om[4 * a + 2] * om[4 * a + 3]); Rp[a] = __shfl_xor(R, 32); Tt[a] = R * Rp[a]; }
    float suf = pc; float w[16];
#pragma unroll
    for (int a = 3; a >= 0; --a) { float c = (hi == 0) ? suf * Rp[a] : suf;
        w[4 * a + 3] = be[4 * a + 3] * c; c *= om[4 * a + 3];
        w[4 * a + 2] = be[4 * a + 2] * c; c *= om[4 * a + 2];
        w[4 * a + 1] = be[4 * a + 1] * c; c *= om[4 * a + 1];
        w[4 * a] = be[4 * a] * c;
        suf *= Tt[a]; }
    pc = suf;
    bf16x8 pf[2];
#pragma unroll
    for (int s = 0; s < 2; ++s) { v4u p; p.x = cvtpk(w[8 * s], w[8 * s + 1]); p.y = cvtpk(w[8 * s + 2], w[8 * s + 3]); p.z = cvtpk(w[8 * s + 4], w[8 * s + 5]); p.w = cvtpk(w[8 * s + 6], w[8 * s + 7]);
        pf[s] = __builtin_bit_cast(bf16x8, p); }
#pragma unroll
    for (int s = 0; s < 2; ++s) {
        { const s16x4 lo = vtr(vl + trb + (16 * s) * VPITCH), hh = vtr(vl + trb + (16 * s + 8) * VPITCH);
          const bf16x8 vf = (bf16x8){lo[0], lo[1], lo[2], lo[3], hh[0], hh[1], hh[2], hh[3]};
          o0 = __builtin_amdgcn_mfma_f32_32x32x16_bf16(vf, pf[s], o0, 0, 0, 0); }
        { const s16x4 lo = vtr(vl + trb + (16 * s) * VPITCH + 64), hh = vtr(vl + trb + (16 * s + 8) * VPITCH + 64);
          const bf16x8 vf = (bf16x8){lo[0], lo[1], lo[2], lo[3], hh[0], hh[1], hh[2], hh[3]};
          o1 = __builtin_amdgcn_mfma_f32_32x32x16_bf16(vf, pf[s], o1, 0, 0, 0); }
    }
    asm volatile("" ::: "memory");
    return kt == 0 || __ballot(pc >= SB_EXIT) == 0ull;
}
__device__ __forceinline__ void attn_unit(const bf16* __restrict__ Q, const bf16* __restrict__ K, const bf16* __restrict__ V, const bf16* __restrict__ ZA, bf16* __restrict__ Y,
                                          int b, int h, int qt, LAS unsigned char* vl, int lane) {
    const int j = lane & 31, hi = lane >> 5;
    const size_t row0 = (size_t)b * SEQ + (size_t)qt * 32;
    const int lr = lane >> 3, lc = lane & 7;
    const unsigned vwb = (unsigned)(lr * VPITCH + lc * 16);
    const unsigned frb = (unsigned)(j * VPITCH + 16 * hi);
    const size_t goff = (row0 + lr) * 512 + h * 64 + lc * 8;
    const bf16* kp = K + goff; const bf16* vp = V + goff;
    v4u ka[4], va[4], kb[4], vb[4], kc[4], vc[4];
    {   v4u qr[4];
#pragma unroll
        for (int i = 0; i < 4; ++i) qr[i] = *(const v4u*)(Q + goff + (size_t)i * 8 * 512);
#pragma unroll
        for (int i = 0; i < 4; ++i) ka[i] = *(const v4u*)(kp + (size_t)i * 8 * 512);
#pragma unroll
        for (int i = 0; i < 4; ++i) va[i] = *(const v4u*)(vp + (size_t)i * 8 * 512);
        {   const int step = (qt > 0) ? 32 * 512 : 0; kp -= step; vp -= step;
#pragma unroll
            for (int i = 0; i < 4; ++i) kb[i] = *(const v4u*)(kp + (size_t)i * 8 * 512);
#pragma unroll
            for (int i = 0; i < 4; ++i) vb[i] = *(const v4u*)(vp + (size_t)i * 8 * 512); }
#pragma unroll
        for (int i = 0; i < 4; ++i) *(LAS v4u*)(vl + KOFF + vwb + i * 8 * VPITCH) = qr[i]; }
    asm volatile("" ::: "memory");
    bf16x8 qf[4];
#pragma unroll
    for (int s = 0; s < 4; ++s) qf[s] = *(const LAS bf16x8*)(vl + KOFF + frb + 32 * s);
    asm volatile("" ::: "memory");
    f32x16 o0, o1;
#pragma unroll
    for (int r = 0; r < 16; ++r) { o0[r] = 0.f; o1[r] = 0.f; }
    float pc = 1.0f;
    const int blk = (lane >> 4) & 1, q4 = (lane & 15) >> 2, p4 = lane & 3;
    const unsigned trb = (unsigned)((4 * hi + q4) * VPITCH + (16 * blk + 4 * p4) * 2);
    for (int kt = qt;;) {
        if (attn_tile(ka, va, kc, vc, kp, vp, kt, qt, qf, o0, o1, pc, vl, vwb, frb, trb, j, hi)) break; --kt;
        if (attn_tile(kb, vb, ka, va, kp, vp, kt, qt, qf, o0, o1, pc, vl, vwb, frb, trb, j, hi)) break; --kt;
        if (attn_tile(kc, vc, kb, vb, kp, vp, kt, qt, qf, o0, o1, pc, vl, vwb, frb, trb, j, hi)) break; --kt;
    }
    v4u zz[4];
#pragma unroll
    for (int i = 0; i < 4; ++i) zz[i] = *(const v4u*)(ZA + goff + (size_t)i * 8 * 512);
#pragma unroll
    for (int a = 0; a < 4; ++a) { const int d0 = 8 * a + 4 * hi;
        *(LAS f32x4*)(vl + j * OPITCH + d0 * 4) = (f32x4){o0[4 * a], o0[4 * a + 1], o0[4 * a + 2], o0[4 * a + 3]};
        *(LAS f32x4*)(vl + j * OPITCH + (32 + d0) * 4) = (f32x4){o1[4 * a], o1[4 * a + 1], o1[4 * a + 2], o1[4 * a + 3]}; }
    asm volatile("" ::: "memory");
#pragma unroll
    for (int i = 0; i < 4; ++i) { const int r = lr + 8 * i;
        const f32x4 a0 = *(const LAS f32x4*)(vl + r * OPITCH + lc * 32), a1 = *(const LAS f32x4*)(vl + r * OPITCH + lc * 32 + 16);
        v4u o; o.x = cvtpk(a0[0] * bflo(zz[i].x), a0[1] * bfhi(zz[i].x)); o.y = cvtpk(a0[2] * bflo(zz[i].y), a0[3] * bfhi(zz[i].y));
        o.z = cvtpk(a1[0] * bflo(zz[i].z), a1[1] * bfhi(zz[i].z)); o.w = cvtpk(a1[2] * bflo(zz[i].w), a1[3] * bfhi(zz[i].w));
        *(v4u*)(Y + (row0 + r) * 1024 + 512 + h * 64 + lc * 8) = o; }
    asm volatile("" ::: "memory");
}

__device__ __forceinline__ void unpack8(const v4u q, float (&f)[8]) { f[0] = bflo(q.x); f[1] = bfhi(q.x); f[2] = bflo(q.y); f[3] = bfhi(q.y); f[4] = bflo(q.z); f[5] = bfhi(q.z); f[6] = bflo(q.w); f[7] = bfhi(q.w); }
template <int W> __device__ __forceinline__ void pool_wave_task(const bf16* __restrict__ VP, const bf16* __restrict__ ZP, bf16* __restrict__ Y, int g, int tblk, int lane) {
    const int t0 = tblk * 32 + (lane >> 4) * 8, pos0 = t0 & (SEQ - 1), ch = g * 128 + (lane & 15) * 8;
    const bf16* vp = VP + (size_t)t0 * 512 + ch; const bf16* zp = ZP + (size_t)t0 * 512 + ch; bf16* yp = Y + (size_t)t0 * 1024 + ch;
    v4u hv[W + 7], zv[8];
#pragma unroll
    for (int i = 0; i < W + 7; ++i) { const int off = i - (W - 1); hv[i] = (pos0 + off >= 0) ? *(const v4u*)(vp + (ptrdiff_t)off * 512) : (v4u){0u, 0u, 0u, 0u}; }
#pragma unroll
    for (int t = 0; t < 8; ++t) zv[t] = *(const v4u*)(zp + (size_t)t * 512);
    float s[8];
#pragma unroll
    for (int e = 0; e < 8; ++e) s[e] = 0.f;
#pragma unroll
    for (int i = 0; i < W - 1; ++i) { float f[8]; unpack8(hv[i], f);
#pragma unroll
        for (int e = 0; e < 8; ++e) s[e] += f[e]; }
#pragma unroll
    for (int t = 0; t < 8; ++t) { float v[8], z[8], y[8]; unpack8(hv[W - 1 + t], v); unpack8(zv[t], z);
        const int cnt = (pos0 + t + 1 < W) ? pos0 + t + 1 : W; const float inv = __builtin_amdgcn_rcpf((float)cnt);
#pragma unroll
        for (int e = 0; e < 8; ++e) { s[e] += v[e]; y[e] = (s[e] * inv - v[e]) * z[e]; }
        v4u o; o.x = cvtpk(y[0], y[1]); o.y = cvtpk(y[2], y[3]); o.z = cvtpk(y[4], y[5]); o.w = cvtpk(y[6], y[7]);
        *(v4u*)(yp + (size_t)t * 1024) = o;
        float f[8]; unpack8(hv[t], f);
#pragma unroll
        for (int e = 0; e < 8; ++e) s[e] -= f[e]; }
}

struct Args { const float* in[10]; float* out; unsigned char* ws; };
__global__ void __launch_bounds__(NTHREADS, 2) fwd_megakernel(Args args) {
    extern __shared__ __attribute__((aligned(16))) unsigned char lds_raw[];
    LAS unsigned char* lds = (LAS unsigned char*)lds_raw;
    const int tid = threadIdx.x, lane = tid & 63, wave = __builtin_amdgcn_readfirstlane(tid >> 6);
    const int G = gridDim.x, bx = blockIdx.x, vcu = (G % 8 == 0) ? (bx % 8) * (G / 8) + bx / 8 : bx;
    const int gw = vcu * NWAVES + wave, NGW = G * NWAVES;
    volatile LAS unsigned* MISC = (volatile LAS unsigned*)(lds + LDS_MISC);
    if (tid < 4) MISC[tid] = 0u;
    __syncthreads();
    (void)xcd_barrier_post((unsigned*)(args.ws + WS_BAR), MISC);
#define GRID_BAR() do { XcdBarrier b_; b_.bar = (unsigned*)(args.ws + WS_BAR); b_.x = xb_xcc_id(); b_.st = (volatile LAS unsigned*)(lds + LDS_MISC); xcd_barrier(b_); } while (0)
    const float* x = args.in[0]; const float* norm_g = args.in[1]; const float* w_in = args.in[2]; const float* b_gate = args.in[3]; const float* pool_w = args.in[4];
    const float* pool_scale = args.in[5]; const float* w_pool_up = args.in[6]; const float* w_attn_up = args.in[7]; const float* w_out = args.in[8]; const float* final_g = args.in[9];
    float* out = args.out; unsigned char* ws = args.ws;
    float* SSP = (float*)(ws + WS_SSP);
    bf16* XG = (bf16*)(ws + WS_XG); bf16* VP = (bf16*)(ws + WS_VP); bf16* ZP = (bf16*)(ws + WS_ZP); bf16* Qb = (bf16*)(ws + WS_Q); bf16* Kb = (bf16*)(ws + WS_K);
    bf16* Vb = (bf16*)(ws + WS_V); bf16* ZA = (bf16*)(ws + WS_ZA); bf16* Gt = (bf16*)(ws + WS_G); bf16* Yb = (bf16*)(ws + WS_Y); bf16* MG = (bf16*)(ws + WS_MG);

#pragma nounroll
    for (int rep = 0; rep < REP_P0; ++rep) {
        LAS float* PW = (LAS float*)lds; LAS float* WI = (LAS float*)(lds + 65536);
        for (int it = vcu; it < 256; it += G) {
            const int l = it >> 7, g = (it >> 5) & 3, k0 = (it & 31) * 32;
            const float* pw = pool_w + ((size_t)l * 4 + g) * 16384; const float* wi = w_in + (size_t)l * DM * NIN + (size_t)k0 * NIN + g * 128;
            __syncthreads();
#pragma unroll 4
            for (int i = 0; i < 32; ++i) PW[tid + 512 * i] = pw[tid + 512 * i];
#pragma unroll
            for (int i = 0; i < 8; ++i) { const int idx = tid + 512 * i; WI[idx] = wi[(size_t)(idx >> 7) * NIN + (idx & 127)]; }
            __syncthreads();
            const int d = tid & 127, kq = tid >> 7; float acc[8];
#pragma unroll
            for (int e = 0; e < 8; ++e) acc[e] = 0.f;
            for (int c = 0; c < 128; ++c) { const float p = PW[c * 128 + d];
#pragma unroll
                for (int e = 0; e < 8; ++e) acc[e] += WI[(kq * 8 + e) * 128 + c] * p; }
            const float sc = pool_scale[l * 512 + g * 128 + d];
            v4u o; o.x = pk2(acc[0] * sc, acc[1] * sc); o.y = pk2(acc[2] * sc, acc[3] * sc); o.z = pk2(acc[4] * sc, acc[5] * sc); o.w = pk2(acc[6] * sc, acc[7] * sc);
            bf16* wt = (bf16*)(ws + WS_W + (size_t)l * W_LAYER);
            *(v4u*)(wt + (size_t)(g * 128 + d) * 1024 + k0 + kq * 8) = o;
        }
        __syncthreads();
        LAS float* scr = (LAS float*)(lds + wave * 16384);
        for (int it = gw; it < 6656; it += NGW) {
            const int l = it / 3328; int r = it % 3328;
            bf16* win_t = (bf16*)(ws + WS_W + (size_t)l * W_LAYER); bf16* wpa_t = win_t + (size_t)NIN * 1024; bf16* wout_t = wpa_t + (size_t)1024 * 1024;
            if (r < 2304) { const int kb = r / 144, nb = r % 144; const int n0 = 512 + nb * 32; int trow = n0;
                if (n0 >= 3072) { const int hg = (n0 - 3072) >> 10, ch0 = (n0 - 3072) & 1023; trow = 3072 + (ch0 >> 7) * 256 + ((ch0 >> 5) & 3) * 64 + hg * 32; }
                tr_item(w_in + (size_t)l * DM * NIN, NIN, win_t, 1024, kb * 64, n0, trow, kb * 64, scr, lane); continue; } r -= 2304;
            if (r < 256) { const int kb = r / 32, nb = r % 32; tr_item(w_pool_up + (size_t)l * 512 * 1024, 1024, wpa_t, 1024, kb * 64, nb * 32, nb * 32, kb * 64, scr, lane); continue; } r -= 256;
            if (r < 256) { const int kb = r / 32, nb = r % 32; tr_item(w_attn_up + (size_t)l * 512 * 1024, 1024, wpa_t, 1024, kb * 64, nb * 32, nb * 32, 512 + kb * 64, scr, lane); continue; } r -= 256;
            { const int kb = r / 32, nb = r % 32; tr_item(w_out + (size_t)l * 1024 * 1024, 1024, wout_t, 1024, kb * 64, nb * 32, nb * 32, kb * 64, scr, lane); }
        }
        for (int m = gw; m < T; m += NGW) {
            const f32x4* xr = (const f32x4*)(x + (size_t)m * DM) + 2 * lane; const f32x4* gr = (const f32x4*)norm_g + 2 * lane;
            f32x4 v[4]; float s = 0.f;
#pragma unroll
            for (int jx = 0; jx < 2; ++jx) { v[2 * jx] = xr[128 * jx]; v[2 * jx + 1] = xr[128 * jx + 1]; }
#pragma unroll
            for (int jx = 0; jx < 4; ++jx) s += (v[jx][0] * v[jx][0] + v[jx][1] * v[jx][1]) + (v[jx][2] * v[jx][2] + v[jx][3] * v[jx][3]);
            s = wave_sum(s);
            v4u* o16 = (v4u*)(XG + (size_t)m * DM) + lane;
#pragma unroll
            for (int jx = 0; jx < 2; ++jx) { const f32x4 g0 = gr[128 * jx], g1 = gr[128 * jx + 1]; const f32x4 a = v[2 * jx], b = v[2 * jx + 1]; v4u o;
                o.x = pk2(a[0] * g0[0], a[1] * g0[1]); o.y = pk2(a[2] * g0[2], a[3] * g0[3]); o.z = pk2(b[0] * g1[0], b[1] * g1[1]); o.w = pk2(b[2] * g1[2], b[3] * g1[3]); o16[64 * jx] = o; }
            if (lane < 16) SSP[(size_t)m * 16 + lane] = (lane == 0) ? s : 0.f;
        }
    }
    GRID_BAR();

    for (int l = 0; l < 2; ++l) {
        const bf16* win_t = (const bf16*)(ws + WS_W + (size_t)l * W_LAYER); const bf16* wpa_t = win_t + (size_t)NIN * 1024; const bf16* wout_t = wpa_t + (size_t)1024 * 1024;
#pragma nounroll
        for (int rep = 0; rep < REP_P1; ++rep) {
            if (STAGGER_P1 && ((bx >> 3) & 1)) { const unsigned long long t0 = __builtin_amdgcn_s_memrealtime(); while (__builtin_amdgcn_s_memrealtime() - t0 < (unsigned long long)STAGGER_P1) __builtin_amdgcn_s_sleep(8); }
            pg8::Gemm g{XG, win_t, T, NIN, DM, DM, DM}; pg8::StaticOrder S; S.init(T, NIN, G, bx);
            pg8::EpiProj E{VP, ZP, Qb, Kb, Vb, ZA, Gt, SSP, b_gate + l * 2048};
            pg8::gemm_phase<pg8::EpiProj, pg8::StaticOrder, true, true>(lds, g, S, E); }
#pragma nounroll
        for (int rep = 0; rep < REP_SYNC; ++rep) GRID_BAR();
#pragma nounroll
        for (int rep = 0; rep < REP_P2; ++rep) {   LAS unsigned char* vl = lds + wave * 16384;
            int ln = lane; asm volatile("" : "+v"(ln));
#pragma nounroll
            for (int ph = 0; ph < 2; ++ph) {
                if ((ph == 0) == (wave >= 4)) {
#pragma nounroll
                    for (int r2 = 0; r2 < REP_ATT; ++r2)
                    for (int u = gw; u < NB * NH * (SEQ / 32); u += NGW) { const int hh = u & 7, qt = (u >> 3) & 255, bb = u >> 11;
                        attn_unit(Qb, Kb, Vb, ZA, Yb, bb, hh, qt, vl, ln); }
                } else {
#pragma nounroll
                    for (int r2 = 0; r2 < REP_POOL; ++r2)
                    for (int wt = gw, i = 0; wt < (T / 32) * 4; wt += NGW, ++i) { int g, tblk;
                        if (G == 256) { const int w8 = wave + 8 * i; g = w8 & 3; tblk = (w8 >> 2) * 256 + vcu; }
                        else { g = wt & 3; tblk = wt >> 2; }
                        if (g == 0) pool_wave_task<2>(VP, ZP, Yb, 0, tblk, ln); else if (g == 1) pool_wave_task<4>(VP, ZP, Yb, 1, tblk, ln);
                        else if (g == 2) pool_wave_task<8>(VP, ZP, Yb, 2, tblk, ln); else pool_wave_task<16>(VP, ZP, Yb, 3, tblk, ln); }
                } } }
        GRID_BAR();
#pragma nounroll
        for (int rep = 0; rep < REP_P3A; ++rep) {   pg8::StaticOrder S; S.init(T, DM, G, bx);
            { pg8::Gemm g{Yb, wpa_t, T, DM, DM, DM, DM}; pg8::EpiMergeMid E{MG, Gt}; pg8::gemm_phase<pg8::EpiMergeMid, pg8::StaticOrder, true, true>(lds, g, S, E); } }
        GRID_BAR();
        const bool fuse_norm = (l == 1 && G == 256);
        if (!fuse_norm) {
#pragma nounroll
        for (int rep = 0; rep < (l == 0 ? REP_P3B : 1); ++rep) {   pg8::Gemm g{MG, wout_t, T, DM, DM, DM, DM}; pg8::StaticOrder S; S.init(T, DM, G, bx);
            pg8::EpiOut E{l == 0 ? x : (const float*)out, out, XG, norm_g + 1024, SSP, l == 0 ? 1 : 0};
            pg8::gemm_phase<pg8::EpiOut, pg8::StaticOrder, true, true>(lds, g, S, E); }
        GRID_BAR();
        } else {
            pg8::Gemm g{MG, wout_t, T, DM, DM, DM, DM}; pg8::StaticOrder S; S.init(T, DM, G, bx);
            pg8::EpiOutNorm E{out, out, final_g, (float*)(ws + WS_XBUF), (unsigned*)(ws + WS_PCNT), lds + LDS_XTAB};
            pg8::gemm_phase<pg8::EpiOutNorm, pg8::StaticOrder, true, true>(lds, g, S, E); }
    }
    if (G != 256) {
#pragma nounroll
    for (int rep = 0; rep < REP_FIN; ++rep)
    for (int m = gw; m < T; m += NGW) {
        float ss = SSP[(size_t)m * 16 + (lane & 15)];
        ss += __shfl_xor(ss, 1); ss += __shfl_xor(ss, 2); ss += __shfl_xor(ss, 4); ss += __shfl_xor(ss, 8);
        const float rstd = __builtin_amdgcn_rsqf(ss * (1.0f / 1024.0f) + 1e-6f);
        f32x4* xr = (f32x4*)(out + (size_t)m * DM) + lane; const f32x4* gr = (const f32x4*)final_g + lane;
        f32x4* xw = (rep == REP_FIN - 1) ? xr : (f32x4*)((float*)(ws + WS_G) + (size_t)m * DM) + lane;
#pragma unroll
        for (int jx = 0; jx < 4; ++jx) { const f32x4 v = xr[64 * jx]; xw[64 * jx] = v * rstd * gr[64 * jx]; }
    }
    }
}

extern "C" void kernel_launch(void* const* d_in, const int* in_sizes, int n_in, void* d_out, int out_size, void* d_ws, size_t ws_size, hipStream_t stream) {
    static int grid = 0;
    if (grid == 0) {
        if (n_in != 10 || in_sizes[0] != T * DM || out_size != T * DM || ws_size < WS_END) { fprintf(stderr, "kernel_launch: unexpected shapes / workspace (ws %zu, need %zu)\n", ws_size, (size_t)WS_END); grid = -1; return; }
        int dev = 0, cus = 0, per_cu = 0;
        hipGetDevice(&dev); hipDeviceGetAttribute(&cus, hipDeviceAttributeMultiprocessorCount, dev);
        hipFuncSetAttribute((const void*)fwd_megakernel, hipFuncAttributeMaxDynamicSharedMemorySize, LDS_BYTES);
        hipOccupancyMaxActiveBlocksPerMultiprocessor(&per_cu, (const void*)fwd_megakernel, NTHREADS, LDS_BYTES);
        if (per_cu < 1) { fprintf(stderr, "kernel_launch: occupancy query says %d blocks per CU\n", per_cu); per_cu = 1; }
        grid = cus * per_cu;
    }
    if (grid < 0) return;
    if (hipMemsetAsync((char*)d_ws + WS_BAR, 0, BAR_ZERO_BYTES, stream) != hipSuccess) { fprintf(stderr, "kernel_launch: memset of the barrier words failed\n"); return; }
    Args a{};
    for (int i = 0; i < 10; ++i) a.in[i] = (const float*)d_in[i];
    a.out = (float*)d_out; a.ws = (unsigned char*)d_ws;
    void* kargs[] = {&a};
    hipError_t e = hipLaunchCooperativeKernel((const void*)fwd_megakernel, dim3(grid), dim3(NTHREADS), kargs, LDS_BYTES, stream);
    if (e != hipSuccess) fprintf(stderr, "cooperative launch failed: %s (grid %d)\n", hipGetErrorString(e), grid);
}
```
